# Optimizing an MI355X kernel written in HIP

```python
import jax, jax.numpy as jnp
from jax import lax
import numpy as np

D_MODEL = 4096
BATCH = 4
SEQ = 4096
DEPTH = 1

GRID_W = 64
CTX_LEN = 256
GLA_VAL_W = D_MODEL // 2
GLA_HEADS = 8
GLA_DV = GLA_VAL_W // GLA_HEADS
GLA_DK = GLA_DV // 2
GLA_KEY_W = GLA_HEADS * GLA_DK
GLA_CHUNK = 64
GLA_LOWRANK = 16
GLA_TAU = 16.0
ROPE_BASE = 10000.0
SG_WIDTH = D_MODEL - GLA_VAL_W
SG_GROUPS = 4
SG_GROUP_W = SG_WIDTH // SG_GROUPS
SG_CHUNK = 128
MIX_W = GLA_VAL_W + SG_WIDTH
D_FF = 4 * D_MODEL
N_MOD = 6
EPS = 1e-6
Q0 = 0
K0 = Q0 + GLA_KEY_W
V0 = K0 + GLA_KEY_W
R0 = V0 + GLA_VAL_W
LF0 = R0 + GLA_VAL_W
LB0 = LF0 + GLA_LOWRANK
SG0 = LB0 + GLA_LOWRANK
IN_COLS = SG0 + 2 * SG_WIDTH

kernel_name = "hybrid_gla_gmlp_prefix_dit_block"


def rmsnorm(t, g):
    tf = t.astype(jnp.float32)
    y = tf * lax.rsqrt(jnp.mean(tf * tf, axis=-1, keepdims=True) + EPS)
    return (y * g.astype(jnp.float32)).astype(t.dtype)


def layernorm(t, g, b):
    tf = t.astype(jnp.float32)
    mu = jnp.mean(tf, axis=-1, keepdims=True)
    var = jnp.mean(jnp.square(tf - mu), axis=-1, keepdims=True)
    y = (tf - mu) * lax.rsqrt(var + EPS)
    return (y * g.astype(jnp.float32) + b.astype(jnp.float32)).astype(t.dtype)


def modulate(h, shift, scale):
    return h * (1.0 + scale) + shift


def split_heads(t, d):
    return t.reshape(t.shape[:-1] + (GLA_HEADS, d))


def flip_seq(t):
    return jnp.flip(t, axis=1)


def rope_axis(t, pos):
    m = t.shape[-1] // 2
    inv_freq = ROPE_BASE ** (-jnp.arange(m, dtype=jnp.float32) / m)
    ang = pos.astype(jnp.float32)[:, None] * inv_freq[None, :]
    cos = jnp.cos(ang)[:, None, :]
    sin = jnp.sin(ang)[:, None, :]
    t1 = t[..., :m].astype(jnp.float32)
    t2 = t[..., m:].astype(jnp.float32)
    return jnp.concatenate([t1 * cos - t2 * sin, t1 * sin + t2 * cos], axis=-1).astype(t.dtype)


def rope2d(t, row_pos, col_pos):
    half = t.shape[-1] // 2
    return jnp.concatenate([rope_axis(t[..., :half], row_pos), rope_axis(t[..., half:], col_pos)], axis=-1)


def gla_qk(z):
    q = split_heads(z[..., Q0:K0], GLA_DK) * (GLA_DK ** -0.5)
    k = split_heads(z[..., K0:V0], GLA_DK)
    return q, k


def gla_log_decay(lr, w_dec, b_dec):
    a = (lr @ w_dec + b_dec).astype(jnp.float32)
    return split_heads(jax.nn.log_sigmoid(a) / GLA_TAU, GLA_DK)


def gla_chunked(q, k, v, log_a, s0):
    bsz, n, h, dk = q.shape
    dv = v.shape[-1]
    nc = n // GLA_CHUNK

    def to_chunks(t):
        return t.astype(jnp.float32).reshape(bsz, nc, GLA_CHUNK, h, t.shape[-1]).transpose(1, 0, 3, 2, 4)

    mask = jnp.tril(jnp.ones((GLA_CHUNK, GLA_CHUNK), dtype=bool))[None, None, :, :, None]

    def step(s, inp):
        qi, ki, vi, ai = inp
        b = jnp.cumsum(ai, axis=2)
        inter = jnp.einsum('bhck,bhkv->bhcv', qi * jnp.exp(b), s)
        diff = b[:, :, :, None, :] - b[:, :, None, :, :]
        decay = jnp.exp(jnp.where(mask, diff, -jnp.inf))
        att = jnp.einsum('bhik,bhjk,bhijk->bhij', qi, ki, decay)
        intra = jnp.einsum('bhij,bhjv->bhiv', att, vi)
        b_last = b[:, :, -1, :]
        s_new = jnp.exp(b_last)[..., None] * s + jnp.einsum(
            'bhck,bhcv->bhkv', ki * jnp.exp(b_last[:, :, None, :] - b), vi)
        return s_new, inter + intra

    s_fin, o = lax.scan(step, s0.astype(jnp.float32), (to_chunks(q), to_chunks(k), to_chunks(v), to_chunks(log_a)))
    o = o.transpose(1, 0, 3, 2, 4).reshape(bsz, n, h, dv)
    return o, s_fin


def gla_final_state(k, v, log_a):
    b = jnp.cumsum(log_a.astype(jnp.float32), axis=1)
    w = jnp.exp(b[:, -1:] - b)
    return jnp.einsum('bnhk,bnhv->bhkv', k.astype(jnp.float32) * w, v.astype(jnp.float32))


def gla_bidir(q, k, v, la_f, la_b, s_f0, s_b0):
    o_f, s_f = gla_chunked(q, k, v, la_f, s_f0)
    o_b, s_b = gla_chunked(flip_seq(q), flip_seq(k), flip_seq(v), flip_seq(la_b), s_b0)
    return o_f + flip_seq(o_b), s_f, s_b


def gla_readout(o, r, g):
    bsz, n = o.shape[0], o.shape[1]
    y = rmsnorm(o, g).astype(r.dtype).reshape(bsz, n, GLA_VAL_W)
    return y * jax.nn.silu(r)


def spatial_gating(zs, ln_g, ln_b, w_s, b_s):
    zs = jax.nn.gelu(zs, approximate=False)
    u, vv = zs[..., :SG_WIDTH], zs[..., SG_WIDTH:]
    vv = layernorm(vv, ln_g, ln_b)
    bsz, n = vv.shape[0], vv.shape[1]
    vv = vv.reshape(bsz, n // SG_CHUNK, SG_CHUNK, SG_GROUPS, SG_GROUP_W)
    s = jnp.einsum('gij,bnjgc->bnigc', w_s, vv) + b_s.T[:, :, None]
    return u * s.reshape(bsz, n, SG_WIDTH)


def token_mix(z, q, k, s_f0, s_b0, w_dec_f, b_dec_f, w_dec_b, b_dec_b,
              gla_norm_g, sg_ln_g, sg_ln_b, w_s, b_s, w_o):
    v = split_heads(z[..., V0:R0], GLA_DV)
    la_f = gla_log_decay(z[..., LF0:LB0], w_dec_f, b_dec_f)
    la_b = gla_log_decay(z[..., LB0:SG0], w_dec_b, b_dec_b)
    o, s_f, s_b = gla_bidir(q, k, v, la_f, la_b, s_f0, s_b0)
    y_gla = gla_readout(o, z[..., R0:LF0], gla_norm_g)
    y_sg = spatial_gating(z[..., SG0:], sg_ln_g, sg_ln_b, w_s, b_s)
    y = jnp.concatenate([y_gla, y_sg], axis=-1) @ w_o
    return y, s_f, s_b


def ctx_states(hc, w_in, w_dec_f, b_dec_f, w_dec_b, b_dec_b):
    k = split_heads(hc @ w_in[:, K0:V0], GLA_DK)
    v = split_heads(hc @ w_in[:, V0:R0], GLA_DV)
    lr = hc @ w_in[:, LF0:SG0]
    la_f = gla_log_decay(lr[..., :GLA_LOWRANK], w_dec_f, b_dec_f)
    la_b = gla_log_decay(lr[..., GLA_LOWRANK:], w_dec_b, b_dec_b)
    s_f = gla_final_state(k, v, la_f)
    s_b = gla_final_state(flip_seq(k), flip_seq(v), flip_seq(la_b))
    return s_f, s_b


def sq_relu_mlp(h, w_1, w_2):
    return jnp.square(jax.nn.relu(h @ w_1)) @ w_2


def setup_inputs(seed: int = 0) -> dict:
    key = jax.random.key(seed)
    ks = jax.random.split(key, 24)

    def nrm(k, shape, scale):
        return jax.random.normal(k, shape, jnp.float32) * scale

    def gain(k, shape):
        return 1.0 + nrm(k, shape, 0.01)

    L = DEPTH
    return {
        "x": nrm(ks[0], (BATCH, SEQ, D_MODEL), 1.0),
        "c": nrm(ks[1], (BATCH, D_MODEL), 1.0),
        "ctx": nrm(ks[2], (BATCH, CTX_LEN, D_MODEL), 1.0),
        "c_ctx": nrm(ks[3], (D_MODEL,), 1.0),
        "w_ada": nrm(ks[4], (L, D_MODEL, N_MOD * D_MODEL), D_MODEL ** -0.5),
        "b_ada": nrm(ks[5], (L, N_MOD * D_MODEL), 0.01),
        "pre1_g": gain(ks[6], (L, D_MODEL)),
        "post1_g": gain(ks[7], (L, D_MODEL)),
        "pre2_g": gain(ks[8], (L, D_MODEL)),
        "post2_g": gain(ks[9], (L, D_MODEL)),
        "w_in": nrm(ks[10], (L, D_MODEL, IN_COLS), D_MODEL ** -0.5),
        "w_dec_f": nrm(ks[11], (L, GLA_LOWRANK, GLA_KEY_W), GLA_LOWRANK ** -0.5),
        "b_dec_f": nrm(ks[12], (L, GLA_KEY_W), 0.1),
        "w_dec_b": nrm(ks[13], (L, GLA_LOWRANK, GLA_KEY_W), GLA_LOWRANK ** -0.5),
        "b_dec_b": nrm(ks[14], (L, GLA_KEY_W), 0.1),
        "gla_norm_g": gain(ks[15], (L, GLA_HEADS, GLA_DV)),
        "sg_ln_g": gain(ks[16], (L, SG_WIDTH)),
        "sg_ln_b": nrm(ks[17], (L, SG_WIDTH), 0.01),
        "w_s": nrm(ks[18], (L, SG_GROUPS, SG_CHUNK, SG_CHUNK), SG_CHUNK ** -0.5),
        "b_s": gain(ks[19], (L, SG_GROUPS, SG_CHUNK)),
        "w_o": nrm(ks[20], (L, MIX_W, D_MODEL), MIX_W ** -0.5),
        "w_1": nrm(ks[21], (L, D_MODEL, D_FF), D_MODEL ** -0.5),
        "w_2": nrm(ks[22], (L, D_FF, D_MODEL), D_FF ** -0.5),
    }


def reference(x, c, ctx, c_ctx, w_ada, b_ada, pre1_g, post1_g, pre2_g, post2_g, w_in,
              w_dec_f, b_dec_f, w_dec_b, b_dec_b, gla_norm_g, sg_ln_g, sg_ln_b, w_s, b_s,
              w_o, w_1, w_2):
    bsz, n = x.shape[0], x.shape[1]
    ROWS = n // GRID_W
    pos = jnp.arange(ROWS * GRID_W)
    row_pos = pos // GRID_W
    col_pos = pos % GRID_W
    zero_state = jnp.zeros((bsz, GLA_HEADS, GLA_DK, GLA_DV), jnp.float32)
    cond_x = jax.nn.silu(c)[:, None, :]
    cond_c = jax.nn.silu(c_ctx)

    for l in range(DEPTH):
        mod_x = cond_x @ w_ada[l] + b_ada[l]
        sh1, sc1, g1, sh2, sc2, g2 = jnp.split(mod_x, N_MOD, axis=-1)
        hx = modulate(rmsnorm(x, pre1_g[l]), sh1, sc1)

        if l == DEPTH - 1:
            mod_c = cond_c @ w_ada[l][:, :2 * D_MODEL] + b_ada[l][:2 * D_MODEL]
            csh1, csc1 = jnp.split(mod_c, 2, axis=-1)
            hc = modulate(rmsnorm(ctx, pre1_g[l]), csh1, csc1)
            s_f, s_b = ctx_states(hc, w_in[l], w_dec_f[l], b_dec_f[l], w_dec_b[l], b_dec_b[l])
        else:
            mod_c = cond_c @ w_ada[l] + b_ada[l]
            csh1, csc1, cg1, csh2, csc2, cg2 = jnp.split(mod_c, N_MOD, axis=-1)
            hc = modulate(rmsnorm(ctx, pre1_g[l]), csh1, csc1)
            zc = hc @ w_in[l]
            qc, kc = gla_qk(zc)
            mix_c, s_f, s_b = token_mix(zc, qc, kc, zero_state, zero_state,
                                        w_dec_f[l], b_dec_f[l], w_dec_b[l], b_dec_b[l],
                                        gla_norm_g[l], sg_ln_g[l], sg_ln_b[l], w_s[l], b_s[l], w_o[l])
            ctx = ctx + cg1 * rmsnorm(mix_c, post1_g[l])
            hc2 = modulate(rmsnorm(ctx, pre2_g[l]), csh2, csc2)
            ctx = ctx + cg2 * rmsnorm(sq_relu_mlp(hc2, w_1[l], w_2[l]), post2_g[l])

        zx = hx @ w_in[l]
        qx, kx = gla_qk(zx)
        qx = rope2d(qx, row_pos, col_pos)
        kx = rope2d(kx, row_pos, col_pos)
        mix_x, _, _ = token_mix(zx, qx, kx, s_f, s_b,
                                w_dec_f[l], b_dec_f[l], w_dec_b[l], b_dec_b[l],
                                gla_norm_g[l], sg_ln_g[l], sg_ln_b[l], w_s[l], b_s[l], w_o[l])
        x = x + g1 * rmsnorm(mix_x, post1_g[l])
        h2 = modulate(rmsnorm(x, pre2_g[l]), sh2, sc2)
        x = x + g2 * rmsnorm(sq_relu_mlp(h2, w_1[l], w_2[l]), post2_g[l])
    return x
```

```cpp
#include <hip/hip_runtime.h>
#include <cstdio>
#include <cstdint>
namespace pg8 {
#define PG8_LAS __attribute__((address_space(3)))
typedef unsigned short bf16_t;
typedef short bf16x8 __attribute__((ext_vector_type(8)));
typedef float f32x4 __attribute__((ext_vector_type(4)));
typedef unsigned u32x4 __attribute__((ext_vector_type(4)));
constexpr int BM = 256, BK = 64, HALF = 128, HTB = HALF * BK * 2  , STAGE_BYTES = 8 * HTB, NXCD = 8, WGM = 8;

__host__ __device__ __forceinline__ int lds_byte(int r, int c) { const int st = (r >> 4) * 2 + (c >> 5), rr = r & 15, cc = c & 31, ob = rr * 64 + cc * 2; return st * 1024 + (ob ^ (((ob >> 9) & 1) << 5)); }
__host__ __device__ __forceinline__ void stage_rc(int b, int& R, int& C) { const int st = b / 1024, sb = b % 1024, swz = sb ^ (((sb >> 9) & 1) << 5); R = (st >> 1) * 16 + swz / 64; C = (st & 1) * 32 + (swz % 64) / 2; }
__host__ __device__ __forceinline__ int perm32(int rho) { const int n = rho >> 4, i = rho & 15; return 8 * (i >> 2) + 4 * n + (i & 3); }

struct Unit { int pm, pn; };
struct Gemm { const bf16_t* A; const bf16_t* Bt; int M, N, K; };

struct StaticOrder {
    int nM, nN, nwg, G, c;
    __host__ __device__ void init(int M, int N, int G_, int c_) { nM = M / BM; nN = N / BM; nwg = nM * nN; G = G_; c = c_; }
    __host__ __device__ bool next(int i, Unit& u) const {
        const long L = (long)i * G + c; if (L >= nwg) return false;
        int wgid = (int)L; { const int q = nwg / NXCD, r = nwg % NXCD, xcd = wgid % NXCD, off = wgid / NXCD; wgid = (xcd < r ? xcd * (q + 1) : r * (q + 1) + (xcd - r) * q) + off; }
        const int nig = WGM * nN, gid = wgid / nig, fm = gid * WGM, gsz = (nM - fm) < WGM ? (nM - fm) : WGM;
        u.pm = fm + ((wgid % nig) % gsz); u.pn = (wgid % nig) / gsz; return true;
    }
    __device__ __forceinline__ void a_ready(const Unit&) const {}
    __device__ __forceinline__ void done(const Unit&) const {}
};

__device__ __forceinline__ unsigned cvt_pk_bf16(float lo, float hi) { unsigned r; asm volatile("v_cvt_pk_bf16_f32 %0, %1, %2" : "=v"(r) : "v"(lo), "v"(hi)); return r; }
typedef float f32x2 __attribute__((ext_vector_type(2)));
__device__ __forceinline__ f32x2 gelu_pk(f32x2 v) {
    const f32x2 av = __builtin_elementwise_abs(v), d = av * 0.2316418882f + 1.0f;
    f32x2 t; t.x = __builtin_amdgcn_rcpf(d.x); t.y = __builtin_amdgcn_rcpf(d.y);
    f32x2 q = t * 0.5307027145f + (-0.7265760135f); q = q * t + 0.7107068705f; q = q * t + (-0.142248368f); q = q * t + 0.127414796f; q = q * t;
    const f32x2 s = (v * v) * (-0.72134752044f);
    f32x2 e; e.x = __builtin_amdgcn_exp2f(s.x); e.y = __builtin_amdgcn_exp2f(s.y);
    const f32x2 m = v * (q * e), r = v - m;
    f32x2 o; o.x = v.x < 0.f ? m.x : r.x; o.y = v.y < 0.f ? m.y : r.y; return o;
}

typedef unsigned u32x2 __attribute__((ext_vector_type(2)));
template <int ACT> __device__ __forceinline__ f32x4 act4(f32x4 v, float sc) {
    if (ACT == 0) return v * sc;
    if (ACT == 1) { f32x4 o;
#pragma unroll
        for (int j = 0; j < 4; ++j) o[j] = v[j] * __builtin_amdgcn_rcpf(1.0f + __expf(-v[j]));
        return o; }
    if (ACT == 2) { const f32x2 a = gelu_pk((f32x2){v[0], v[1]}), b = gelu_pk((f32x2){v[2], v[3]}); return (f32x4){a.x, a.y, b.x, b.y}; }
    { f32x4 o;
#pragma unroll
        for (int j = 0; j < 4; ++j) { const float t = v[j] > 0.f ? v[j] : 0.f; o[j] = t * t; }
        return o; }
}
template <int ACT, int STAT> __device__ __forceinline__ void store_tile(const f32x4 (&acc)[2][2][4][2], bf16_t* base, int ldc, int row0, int col0, float sc, float* stat, int slot, int fq) {
#pragma unroll
    for (int ai = 0; ai < 2; ++ai)
#pragma unroll
        for (int m = 0; m < 4; ++m) { const int row = row0 + ai * HALF + m * 16; bf16_t* rowp = base + (size_t)row * ldc + col0; float s1 = 0.f, s2 = 0.f;
#pragma unroll
            for (int bj = 0; bj < 2; ++bj) { const f32x4 v0 = act4<ACT>(acc[ai][bj][m][0], sc), v1 = act4<ACT>(acc[ai][bj][m][1], sc);
                if (STAT) { s1 += (v0[0] + v0[1]) + (v0[2] + v0[3]) + (v1[0] + v1[1]) + (v1[2] + v1[3]);
                            s2 += (v0[0] * v0[0] + v0[1] * v0[1]) + (v0[2] * v0[2] + v0[3] * v0[3]) + (v1[0] * v1[0] + v1[1] * v1[1]) + (v1[2] * v1[2] + v1[3] * v1[3]); }
                u32x4 w; w.x = cvt_pk_bf16(v0[0], v0[1]); w.y = cvt_pk_bf16(v0[2], v0[3]); w.z = cvt_pk_bf16(v1[0], v1[1]); w.w = cvt_pk_bf16(v1[2], v1[3]);
                *(u32x4*)(rowp + bj * HALF) = w; }
            if (STAT) { s2 += __shfl_xor(s2, 16); s2 += __shfl_xor(s2, 32);
                if (STAT == 2) { s1 += __shfl_xor(s1, 16); s1 += __shfl_xor(s1, 32); if (fq == 0) *(f32x2*)(stat + ((size_t)row * 32 + slot) * 2) = (f32x2){s1, s2}; }
                else { if (fq == 0) stat[(size_t)row * 64 + slot] = s2; } } }
}
struct EpiIn {
    static constexpr bool PERM = true, AFTER_DRAIN = false;
    bf16_t *Q, *Kb, *V, *SR, *U, *VV; float* LR; float* sgstat; float qscale;
    __device__ __forceinline__ void operator()(const f32x4 (&acc)[2][2][4][2], const Unit& u, int wr, int wc, int fr, int fq) const {
        const int pn = u.pn, row0 = u.pm * BM + wr * 64 + fr, cw = wc * 32 + 8 * fq;
        if (pn < 4)       store_tile<0, 0>(acc, Q, 1024, row0, pn * 256 + cw, qscale, nullptr, 0, fq);
        else if (pn < 8)  store_tile<0, 0>(acc, Kb, 1024, row0, (pn - 4) * 256 + cw, 1.0f, nullptr, 0, fq);
        else if (pn < 16) store_tile<0, 0>(acc, V, 2048, row0, (pn - 8) * 256 + cw, 1.0f, nullptr, 0, fq);
        else if (pn < 24) store_tile<1, 0>(acc, SR, 2048, row0, (pn - 16) * 256 + cw, 1.0f, nullptr, 0, fq);
        else if (pn < 32) store_tile<2, 0>(acc, U, 2048, row0, (pn - 24) * 256 + cw, 1.0f, nullptr, 0, fq);
        else if (pn < 40) store_tile<2, 2>(acc, VV, 2048, row0, (pn - 32) * 256 + cw, 1.0f, sgstat, (pn - 32) * 4 + wc, fq);
        else if (wc == 0) {
#pragma unroll
            for (int ai = 0; ai < 2; ++ai)
#pragma unroll
                for (int m = 0; m < 4; ++m) { float* p = LR + (size_t)(row0 + ai * HALF + m * 16) * 32 + 8 * fq; *(f32x4*)p = acc[ai][0][m][0]; *(f32x4*)(p + 4) = acc[ai][0][m][1]; }
        }
    }
};
struct InOrder {
    int G, c;
    __device__ bool next(int i, Unit& u) const {
        const int L = i * G + c; constexpr int nM = 64, nN = 40, nwg = nM * nN;
        if (L >= nwg) return false;
        int wgid = L; { const int q = nwg / NXCD, xcd = wgid % NXCD, off = wgid / NXCD; wgid = xcd * q + off; }
        const int nig = WGM * nN, gid = wgid / nig, fm = gid * WGM;
        u.pm = fm + ((wgid % nig) % WGM); u.pn = (wgid % nig) / WGM; return true;
    }
    __device__ __forceinline__ void a_ready(const Unit&) const {}
    __device__ __forceinline__ void done(const Unit&) const {}
};
constexpr int N_TAIL = 116;
struct TailOrder {
    int G, c;
    __device__ bool next(int i, Unit& u) const {
        const int L = i * G + c; if (L >= N_TAIL) return false;
        if (L < 68) { u.pm = L; u.pn = 40; } else { const int x = L - 68; u.pm = 64 + x / 12; u.pn = 4 + x % 12; }
        return true;
    }
    __device__ __forceinline__ void a_ready(const Unit&) const {}
    __device__ __forceinline__ void done(const Unit&) const {}
};
template <int ACT, int STAT> struct EpiAct {
    static constexpr bool PERM = true, AFTER_DRAIN = false;
    bf16_t* O; int ldc; float* stat;
    __device__ __forceinline__ void operator()(const f32x4 (&acc)[2][2][4][2], const Unit& u, int wr, int wc, int fr, int fq) const {
        store_tile<ACT, STAT>(acc, O, ldc, u.pm * BM + wr * 64 + fr, u.pn * BM + wc * 32 + 8 * fq, 1.0f, stat, u.pn * 4 + wc, fq);
    }
};
template <class Epi, class Sched, bool ALIGN_EPI = false, bool SP2 = false>
__device__ __forceinline__ void gemm_phase(PG8_LAS unsigned char* lds, const Gemm g, const Sched& S, const Epi& E) {
    int tid_ = threadIdx.x; asm volatile("" : "+v"(tid_));
    const int tid = tid_, wid = __builtin_amdgcn_readfirstlane(tid >> 6), lane = tid & 63, wr = wid >> 2, wc = wid & 3, fr = lane & 15, fq = lane >> 4;
    const int K = g.K, nt = K / BK;
    unsigned voffA[2], voffB[2];
#pragma unroll
    for (int i = 0; i < 2; ++i) { int R, C; stage_rc(tid * 16 + i * 8192, R, C); const int Rb = Epi::PERM ? ((R & ~31) + perm32(R & 31)) : R;
        voffA[i] = (unsigned)(R * K + C) * 2u; voffB[i] = (unsigned)(Rb * K + C) * 2u; }
    const size_t kstep = (size_t)(BK * 2);
    const size_t hstep = (size_t)HALF * K * 2;
    const size_t tstep = 2 * hstep;
    const unsigned ldsw = (unsigned)wid * 1024u;
    const int aoff = lds_byte(wr * 64 + fr, fq * 8), boff = lds_byte(wc * 32 + fr, fq * 8);
#define PG8_SA(b, h) (((b) * 2 + (h)) * HTB)
#define PG8_SB(b, h) ((4 + (b) * 2 + (h)) * HTB)
#define PG8_STAGE(bufoff, gbase, voff) do { _Pragma("unroll") for (int _i = 0; _i < 2; ++_i) \
        __builtin_amdgcn_global_load_lds((const unsigned*)((const char*)(gbase) + (voff)[_i]), (PG8_LAS unsigned*)(lds + (bufoff) + ldsw + _i * 8192), 16, 0, 0); } while (0)
#define PG8_LDA(dst, b, h) do { _Pragma("unroll") for (int m = 0; m < 4; ++m) _Pragma("unroll") for (int k = 0; k < 2; ++k) dst[m][k] = *(const PG8_LAS bf16x8*)(lds + PG8_SA(b, h) + aoff + m * 2048 + k * 1024); } while (0)
#define PG8_LDB(dst, b, h) do { _Pragma("unroll") for (int n = 0; n < 2; ++n) _Pragma("unroll") for (int k = 0; k < 2; ++k) dst[n][k] = *(const PG8_LAS bf16x8*)(lds + PG8_SB(b, h) + boff + n * 2048 + k * 1024); } while (0)
#define PG8_MMA(ai, bj, At, Bt) do { __builtin_amdgcn_s_setprio(1); _Pragma("unroll") for (int m = 0; m < 4; ++m) _Pragma("unroll") for (int n = 0; n < 2; ++n) _Pragma("unroll") for (int k = 0; k < 2; ++k) \
        acc[ai][bj][m][n] = __builtin_amdgcn_mfma_f32_16x16x32_bf16(Bt[n][k], At[m][k], acc[ai][bj][m][n], 0, 0, 0); __builtin_amdgcn_s_setprio(0); } while (0)
#define PG8_WAIT_V(n) asm volatile("s_waitcnt vmcnt(" #n ")" ::: "memory")
#define PG8_WAIT_L(n) asm volatile("s_waitcnt lgkmcnt(" #n ")" ::: "memory")
#define PG8_BAR __builtin_amdgcn_s_barrier()
#define PG8_SCHED __builtin_amdgcn_sched_barrier(0)
    Unit cur, nxt; int ui = 0;
    if (!S.next(0, cur)) return;
    f32x4 acc[2][2][4][2];
#pragma unroll
    for (int a = 0; a < 2; ++a)
#pragma unroll
        for (int b = 0; b < 2; ++b)
#pragma unroll
            for (int m = 0; m < 4; ++m)
#pragma unroll
                for (int n = 0; n < 2; ++n) acc[a][b][m][n] = (f32x4){0.f, 0.f, 0.f, 0.f};
    bf16x8 At[4][2], B0[2][2], B1[2][2];
    const char* cA = (const char*)g.A + (size_t)cur.pm * tstep; const char* cB = (const char*)g.Bt + (size_t)cur.pn * tstep;
    S.a_ready(cur);
    if constexpr (SP2) {
        PG8_STAGE(PG8_SB(0, 0), cB, voffB); PG8_STAGE(PG8_SB(0, 1), cB + hstep, voffB); PG8_STAGE(PG8_SA(0, 0), cA, voffA); PG8_STAGE(PG8_SA(0, 1), cA + hstep, voffA);
        if (wr == 1) PG8_BAR;
        PG8_WAIT_V(2); PG8_BAR;
        PG8_STAGE(PG8_SB(1, 0), cB + kstep, voffB); PG8_STAGE(PG8_SA(1, 0), cA + kstep, voffA); PG8_STAGE(PG8_SB(1, 1), cB + hstep + kstep, voffB);
        PG8_WAIT_V(6); PG8_BAR;
    } else {
        PG8_STAGE(PG8_SB(0, 0), cB, voffB); PG8_STAGE(PG8_SA(0, 0), cA, voffA); PG8_STAGE(PG8_SB(0, 1), cB + hstep, voffB); PG8_STAGE(PG8_SA(0, 1), cA + hstep, voffA);
        if (wr == 1) PG8_BAR;
        PG8_WAIT_V(4); PG8_BAR;
        PG8_STAGE(PG8_SB(1, 0), cB + kstep, voffB); PG8_STAGE(PG8_SA(1, 0), cA + kstep, voffA); PG8_STAGE(PG8_SB(1, 1), cB + hstep + kstep, voffB);
        PG8_WAIT_V(6); PG8_BAR;
    }
    for (;;) {
        const bool has_next = S.next(ui + 1, nxt);
        const char* nA = has_next ? (const char*)g.A + (size_t)nxt.pm * tstep : cA; const char* nB = has_next ? (const char*)g.Bt + (size_t)nxt.pn * tstep : cB;
        for (int t = 0; t < nt; t += 2) {
            const bool last = (t == nt - 2);
            const char* a1 = cA + (size_t)(t + 1) * kstep;
            const char* a2 = last ? nA : cA + (size_t)(t + 2) * kstep; const char* b2 = last ? nB : cB + (size_t)(t + 2) * kstep;
            const char* a3 = a2 + kstep; const char* b3 = b2 + kstep;
            if (last && has_next) S.a_ready(nxt);
            if constexpr (SP2) {
            PG8_LDB(B0, 0, 0); PG8_LDB(B1, 0, 1); PG8_SCHED; PG8_LDA(At, 0, 0); PG8_STAGE(PG8_SA(1, 1), a1 + hstep, voffA);
            PG8_WAIT_V(8); PG8_WAIT_L(0); PG8_BAR; PG8_MMA(0, 0, At, B0); PG8_MMA(0, 1, At, B1); PG8_BAR; PG8_SCHED;
            PG8_LDA(At, 0, 1); PG8_STAGE(PG8_SB(0, 0), b2, voffB); PG8_STAGE(PG8_SB(0, 1), b2 + hstep, voffB); PG8_STAGE(PG8_SA(0, 0), a2, voffA);
            PG8_WAIT_V(8); PG8_WAIT_L(0); PG8_BAR; PG8_MMA(1, 0, At, B0); PG8_MMA(1, 1, At, B1); PG8_BAR; PG8_SCHED;
            PG8_LDB(B0, 1, 0); PG8_LDB(B1, 1, 1); PG8_SCHED; PG8_LDA(At, 1, 0); PG8_STAGE(PG8_SA(0, 1), a2 + hstep, voffA);
            PG8_WAIT_V(8); PG8_WAIT_L(0); PG8_BAR; PG8_MMA(0, 0, At, B0); PG8_MMA(0, 1, At, B1); PG8_BAR; PG8_SCHED;
            PG8_LDA(At, 1, 1); PG8_STAGE(PG8_SB(1, 0), b3, voffB); PG8_STAGE(PG8_SB(1, 1), b3 + hstep, voffB); PG8_STAGE(PG8_SA(1, 0), a3, voffA);
            PG8_WAIT_V(8); PG8_WAIT_L(0); PG8_BAR; PG8_MMA(1, 0, At, B0); PG8_MMA(1, 1, At, B1); PG8_BAR; PG8_SCHED;
            } else {
            PG8_LDB(B0, 0, 0); PG8_SCHED; PG8_LDA(At, 0, 0); PG8_STAGE(PG8_SA(1, 1), a1 + hstep, voffA);
            PG8_WAIT_L(8); PG8_BAR; PG8_WAIT_L(0); PG8_MMA(0, 0, At, B0); PG8_BAR; PG8_SCHED;
            PG8_LDB(B1, 0, 1); PG8_STAGE(PG8_SB(0, 0), b2, voffB);
            PG8_BAR; PG8_WAIT_L(0); PG8_MMA(0, 1, At, B1); PG8_BAR;
            PG8_LDA(At, 0, 1); PG8_STAGE(PG8_SA(0, 0), a2, voffA);
            PG8_BAR; PG8_WAIT_L(0); PG8_MMA(1, 0, At, B0); PG8_BAR; PG8_SCHED;
            PG8_STAGE(PG8_SB(0, 1), b2 + hstep, voffB);
            PG8_WAIT_V(6); PG8_BAR; PG8_MMA(1, 1, At, B1); PG8_BAR;
            PG8_LDB(B0, 1, 0); PG8_SCHED; PG8_LDA(At, 1, 0); PG8_STAGE(PG8_SA(0, 1), a2 + hstep, voffA);
            PG8_WAIT_L(8); PG8_BAR; PG8_WAIT_L(0); PG8_MMA(0, 0, At, B0); PG8_BAR; PG8_SCHED;
            PG8_LDB(B1, 1, 1); PG8_STAGE(PG8_SB(1, 0), b3, voffB);
            PG8_BAR; PG8_WAIT_L(0); PG8_MMA(0, 1, At, B1); PG8_BAR;
            PG8_LDA(At, 1, 1); PG8_STAGE(PG8_SA(1, 0), a3, voffA);
            PG8_BAR; PG8_WAIT_L(0); PG8_MMA(1, 0, At, B0); PG8_BAR; PG8_SCHED;
            PG8_STAGE(PG8_SB(1, 1), b3 + hstep, voffB);
            PG8_WAIT_V(6); PG8_BAR; PG8_MMA(1, 1, At, B1); PG8_BAR;
            }
        }
        if constexpr (ALIGN_EPI) { if (wr == 0) PG8_BAR; }
        if constexpr (!Epi::AFTER_DRAIN) { E(acc, cur, wr, wc, fr, fq); S.done(cur); }
        if (!has_next) break;
#pragma unroll
        for (int a = 0; a < 2; ++a)
#pragma unroll
            for (int b = 0; b < 2; ++b)
#pragma unroll
                for (int m = 0; m < 4; ++m)
#pragma unroll
                    for (int n = 0; n < 2; ++n) acc[a][b][m][n] = (f32x4){0.f, 0.f, 0.f, 0.f};
        cur = nxt; cA = nA; cB = nB; ++ui;
        if constexpr (ALIGN_EPI) { if (wr == 1) PG8_BAR; }
    }
    PG8_WAIT_V(0);
    if constexpr (!ALIGN_EPI) { if (wr == 0) PG8_BAR; }
    PG8_BAR;
    if constexpr (Epi::AFTER_DRAIN) { E.fused(acc, cur, wr, wc, fr, fq, lds, wid, lane); S.done(cur); }
#undef PG8_SA
#undef PG8_SB
#undef PG8_STAGE
#undef PG8_LDA
#undef PG8_LDB
#undef PG8_MMA
#undef PG8_WAIT_V
#undef PG8_WAIT_L
#undef PG8_BAR
#undef PG8_SCHED
}
}

constexpr int NWAVES = 8, NTHR = 512;
constexpr int BATCH = 4, SEQ = 4096, D = 4096, CTXL = 256, M = BATCH * SEQ, MC = BATCH * CTXL, MT = M + MC;
constexpr int HEADS = 8, DK = 128, DV = 256, KEYW = 1024, VALW = 2048, LOWR = 16, SGW = 2048, SGG = 4, SGGW = 512, SGC = 128, FF = 16384, NMOD = 6;
constexpr int IN_COLS = 10272, IN_PAD = 10496;
constexpr int C_LF = 6144, C_SG = 6176;
constexpr float EPS = 1e-6f;

constexpr size_t MiB = 1u << 20;
constexpr size_t WS_CTL = 0, CTL_ZERO_BYTES = 64 * 1024;
constexpr size_t WS_MOD = 1 * MiB;
constexpr size_t WS_ROPE = 2 * MiB;
constexpr size_t WS_SGSTAT = 3 * MiB;
constexpr size_t WS_SSQ = 7 * MiB;
constexpr size_t WS_WIN = 16 * MiB, WS_WO = 98 * MiB, WS_W1 = 130 * MiB, WS_W2 = 258 * MiB;
constexpr size_t WS_A1 = 386 * MiB;
constexpr size_t WS_Q = 522 * MiB, WS_KB = 554 * MiB, WS_V = 588 * MiB, WS_SR = 656 * MiB, WS_U = 720 * MiB, WS_VV = 784 * MiB, WS_LR = 848 * MiB, WS_OF = 851 * MiB, WS_OB = 915 * MiB, WS_Y = 979 * MiB;
constexpr size_t WS_HMID = 522 * MiB;
constexpr size_t WS_MIX = 1107 * MiB;
constexpr size_t WS_END = 1235 * MiB;
static_assert(WS_WIN + (size_t)IN_PAD * D * 2 <= WS_WO && WS_A1 + (size_t)MT * D * 2 <= WS_Q && WS_KB + (size_t)MT * KEYW * 2 <= WS_V && WS_V + (size_t)MT * VALW * 2 <= WS_SR && WS_LR + (size_t)MT * 32 * 4 <= WS_OF && WS_HMID + (size_t)M * FF * 2 <= WS_MIX && WS_Y + (size_t)M * D * 2 <= WS_MIX, "d_ws map");
constexpr int CW_BAR = 4096, CW_VB = 12288;

constexpr int LDS_CTL_OFF = 155648, LDS_BYTES = 159744;

#define GAS __attribute__((address_space(1)))
#define LAS __attribute__((address_space(3)))
typedef unsigned short bf16;
typedef unsigned v4u __attribute__((ext_vector_type(4)));
typedef unsigned v2u __attribute__((ext_vector_type(2)));
typedef float f32x4 __attribute__((ext_vector_type(4)));
typedef float f32x2 __attribute__((ext_vector_type(2)));
typedef short bf16x8 __attribute__((ext_vector_type(8)));
typedef GAS unsigned gu32;
#define LDS_WAIT() asm volatile("s_waitcnt lgkmcnt(0)" ::: "memory")
#define LDS_BARRIER() asm volatile("s_waitcnt lgkmcnt(0)\n\ts_barrier" ::: "memory")
__device__ __forceinline__ unsigned f2bf(float f) { unsigned u = __builtin_bit_cast(unsigned, f); return (u + 0x7fffu + ((u >> 16) & 1u)) >> 16; }
typedef __bf16 bf16x2_hw __attribute__((ext_vector_type(2)));
__device__ __forceinline__ unsigned pk2(float lo, float hi) { const f32x2 v = {lo, hi}; return __builtin_bit_cast(unsigned, __builtin_convertvector(v, bf16x2_hw)); }
__device__ __forceinline__ float bf_lo(unsigned w) { return __builtin_bit_cast(float, w << 16); }
__device__ __forceinline__ float bf_hi(unsigned w) { return __builtin_bit_cast(float, w & 0xffff0000u); }
__device__ __forceinline__ float bf1(bf16 h) { return __builtin_bit_cast(float, (unsigned)h << 16); }
__device__ __forceinline__ float wave_sum(float v) {
#pragma unroll
    for (int o = 1; o < 64; o <<= 1) v += __shfl_xor(v, o);
    return v;
}
__device__ __forceinline__ void st_global_b64(void* p, v2u v) { asm volatile("global_store_dwordx2 %0, %1, off\n\ts_nop 1" :: "v"(p), "v"(v) : "memory"); }
__device__ __forceinline__ void st_global_b128(void* p, v4u v) { asm volatile("global_store_dwordx4 %0, %1, off\n\ts_nop 1" :: "v"(p), "v"(v) : "memory"); }
#define XB_TMO      128
#define XB_XCNT(j)  (256  + 64 * (j))
#define XB_XSUB(j)  (1280 + 64 * (j))
#define XB_XGEN(j)  (2304 + 64 * (j))
#define XB_TOP      3328
#define XB_TOPGEN   3392
#define XCD_BAR_WORDS 3456
#define XB_SPIN_CAP (1u << 18)

__device__ __forceinline__ unsigned xb_ld(unsigned* p)              { return __hip_atomic_load(p, __ATOMIC_RELAXED, __HIP_MEMORY_SCOPE_AGENT); }
__device__ __forceinline__ unsigned xb_add(unsigned* p, unsigned v) { return __hip_atomic_fetch_add(p, v, __ATOMIC_RELAXED, __HIP_MEMORY_SCOPE_AGENT); }
__device__ __forceinline__ unsigned xb_xcc_id() { return (unsigned)__builtin_amdgcn_s_getreg((3 << 11) | 20) & 0xFu; }
#define XB_SPIN(cond, bar) do { unsigned _sp = 0; while (cond) { __builtin_amdgcn_s_sleep(1); \
    if ((++_sp & 255u) == 0u) { if (xb_ld(&(bar)[XB_TMO])) break; if (_sp > XB_SPIN_CAP) { atomicAdd(&(bar)[XB_TMO], 1u); break; } } } } while (0)

struct XcdBarrier {
    unsigned* bar; unsigned x;
    volatile LAS unsigned* st;
};

__device__ __forceinline__ XcdBarrier xcd_barrier_post(unsigned* bar, volatile LAS unsigned* st) {
    XcdBarrier b; b.bar = bar; b.x = xb_xcc_id(); b.st = st;
    if (threadIdx.x == 0) (void)xb_add(&bar[XB_XCNT(b.x)], 1u);
    return b;
}
__device__ __forceinline__ void xcd_barrier_complete(unsigned* bar, unsigned x, unsigned& nloc, unsigned& nx) {
    const unsigned G = gridDim.x * gridDim.y * gridDim.z;
    unsigned sum, cnt, mine, sp = 0u;
    for (;;) {
        sum = 0u; cnt = 0u; mine = 0u;
#pragma unroll
        for (unsigned j = 0; j < 16; ++j) { const unsigned c = xb_ld(&bar[XB_XCNT(j)]); sum += c; cnt += (c > 0u) ? 1u : 0u; mine = (j == x) ? c : mine; }
        if (sum == G) break;
        __builtin_amdgcn_s_sleep(1);
        if ((++sp & 255u) == 0u) { if (xb_ld(&bar[XB_TMO])) break; if (sp > XB_SPIN_CAP) { atomicAdd(&bar[XB_TMO], 1u); break; } }
    }
    nloc = mine > 0u ? mine : 1u; nx = cnt > 0u ? cnt : 1u;
}

__device__ __forceinline__ void xcd_barrier(const XcdBarrier& b) {
    asm volatile("s_waitcnt vmcnt(0)" ::: "memory");
    __syncthreads();
    if (threadIdx.x == 0) {
        unsigned* bar = b.bar;
        __builtin_amdgcn_s_waitcnt(0);
        unsigned nloc = b.st[0], nx = b.st[1];
        if (nloc == 0u) { xcd_barrier_complete(bar, b.x, nloc, nx); b.st[0] = nloc; b.st[1] = nx; }
        const unsigned old = xb_add(&bar[XB_XSUB(b.x)], 1u);
        const unsigned gen = old / nloc;
        if (old + 1u == (gen + 1u) * nloc) {
            __builtin_amdgcn_fence(__ATOMIC_RELEASE, "agent");
            asm volatile("s_waitcnt vmcnt(0)" ::: "memory");
            const unsigned og = xb_add(&bar[XB_TOP], 1u);
            const unsigned tg = og / nx;
            if (og + 1u == (tg + 1u) * nx) xb_add(&bar[XB_TOPGEN], 1u);
            else XB_SPIN(xb_ld(&bar[XB_TOPGEN]) == tg, bar);
            __builtin_amdgcn_fence(__ATOMIC_ACQUIRE, "agent");
            xb_add(&bar[XB_XGEN(b.x)], 1u);
            asm volatile("s_waitcnt vmcnt(0)" ::: "memory");
        } else {
            XB_SPIN(xb_ld(&bar[XB_XGEN(b.x)]) == gen, bar);
            __builtin_amdgcn_fence(__ATOMIC_ACQUIRE, "agent");
            asm volatile("s_waitcnt vmcnt(0)" ::: "memory");
        }
    }
    __syncthreads();
}

struct Params { const float* in[23]; float* out; unsigned char* ws; };
struct Frame {
    LAS unsigned char* lds;
    int tid, lane, wave, G, bid;
};
__device__ __forceinline__ Frame mk_frame(LAS unsigned char* lds) { Frame F; int t = threadIdx.x; asm volatile("" : "+v"(t));
    F.lds = lds; F.tid = t; F.lane = t & 63; F.wave = __builtin_amdgcn_readfirstlane(t >> 6); F.G = gridDim.x; F.bid = blockIdx.x; return F; }
enum { I_X = 0, I_C, I_CTX, I_CCTX, I_WADA, I_BADA, I_PRE1, I_POST1, I_PRE2, I_POST2, I_WIN, I_WDF, I_BDF, I_WDB, I_BDB, I_GNG, I_SGLG, I_SGLB, I_WS, I_BS, I_WO, I_W1, I_W2 };

__device__ __forceinline__ void p0_transpose_item(const float* W, int K, int N, bf16* WT, int k0, int n0, int dst_row, LAS float* scr, int lane) {
    f32x4 v[16]; const int lr = lane >> 4, lc = (lane & 15) * 4;
#pragma unroll
    for (int i = 0; i < 16; ++i) v[i] = __builtin_nontemporal_load((const f32x4*)(W + (size_t)(k0 + 4 * i + lr) * N + n0 + lc));
#pragma unroll
    for (int i = 0; i < 16; ++i) { LAS float* d = scr + (4 * i + lr) * 65 + lc; d[0] = v[i][0]; d[1] = v[i][1]; d[2] = v[i][2]; d[3] = v[i][3]; }
    LDS_WAIT(); asm volatile("" ::: "memory");
    const int c = lane & 7;
#pragma unroll
    for (int j = 0; j < 8; ++j) { const int n = (lane >> 3) + 8 * j; const LAS float* s = scr + (8 * c) * 65 + n;
        v4u o; o.x = pk2(s[0 * 65], s[1 * 65]); o.y = pk2(s[2 * 65], s[3 * 65]); o.z = pk2(s[4 * 65], s[5 * 65]); o.w = pk2(s[6 * 65], s[7 * 65]);
        *(v4u*)(WT + (size_t)(dst_row + n) * K + k0 + 8 * c) = o; }
    LDS_WAIT(); asm volatile("" ::: "memory");
}
__device__ __forceinline__ float silu_f(float v) { return v / (1.0f + __expf(-v)); }

__device__ __forceinline__ void p0_adaln(LAS unsigned char* lds_, const Params& p) {
    const Frame F = mk_frame(lds_);
    unsigned char* ws = p.ws;
    {
        LAS float* sc = (LAS float*)F.lds;
        LAS float* red = (LAS float*)(F.lds + 81920);
        { f32x4 cv[10];
#pragma unroll
          for (int j = 0; j < 10; ++j) { const int i4 = F.tid + NTHR * j, r = i4 >> 10, k4 = i4 & 1023; cv[j] = *(const f32x4*)((r < 4 ? p.in[I_C] + r * D : p.in[I_CCTX]) + 4 * k4); }
#pragma unroll
          for (int j = 0; j < 10; ++j) { const int i4 = F.tid + NTHR * j; *(LAS f32x4*)(sc + 4 * i4) = (f32x4){silu_f(cv[j][0]), silu_f(cv[j][1]), silu_f(cv[j][2]), silu_f(cv[j][3])}; } }
        __syncthreads();
        const float* W = p.in[I_WADA]; const float* bA = p.in[I_BADA]; float* mod = (float*)(ws + WS_MOD);
        constexpr int NT = NMOD * D;
        for (int cb = F.bid; cb < NT / 96; cb += F.G) {
            const int r8 = F.lane >> 3, c = F.lane & 7;
            f32x4 a[5][3];
#pragma unroll
            for (int r = 0; r < 5; ++r)
#pragma unroll
                for (int q = 0; q < 3; ++q) a[r][q] = (f32x4){0.f, 0.f, 0.f, 0.f};
            const float* wp = W + (size_t)(F.wave * 512 + r8) * NT + cb * 96 + 4 * c;
            f32x4 wa[4][3], wb[4][3];
#define ADA_LD(Wv, it0) do { _Pragma("unroll") for (int u = 0; u < 4; ++u) { const float* wr = wp + (size_t)(8 * ((it0) + u)) * NT; Wv[u][0] = __builtin_nontemporal_load((const f32x4*)(wr)); Wv[u][1] = __builtin_nontemporal_load((const f32x4*)(wr + 32)); Wv[u][2] = __builtin_nontemporal_load((const f32x4*)(wr + 64)); } } while (0)
#define ADA_USE(Wv, it0) do { _Pragma("unroll") for (int u = 0; u < 4; ++u) { const int k = F.wave * 512 + 8 * ((it0) + u) + r8; \
                _Pragma("unroll") for (int r = 0; r < 5; ++r) { const float sv = sc[r * D + k]; a[r][0] += Wv[u][0] * sv; a[r][1] += Wv[u][1] * sv; a[r][2] += Wv[u][2] * sv; } } } while (0)
            ADA_LD(wa, 0);
#pragma unroll 1
            for (int it = 0; it < 64; it += 8) { ADA_LD(wb, it + 4); ADA_USE(wa, it); if (it + 8 < 64) ADA_LD(wa, it + 8); ADA_USE(wb, it + 4); }
#undef ADA_LD
#undef ADA_USE
#pragma unroll
            for (int r = 0; r < 5; ++r)
#pragma unroll
                for (int q = 0; q < 3; ++q)
#pragma unroll
                    for (int j = 0; j < 4; ++j) { float v = a[r][q][j]; v += __shfl_xor(v, 8); v += __shfl_xor(v, 16); v += __shfl_xor(v, 32); a[r][q][j] = v; }
            if (r8 == 0) {
#pragma unroll
                for (int r = 0; r < 5; ++r)
#pragma unroll
                    for (int q = 0; q < 3; ++q) *(LAS f32x4*)(red + (F.wave * 5 + r) * 96 + 32 * q + 4 * c) = a[r][q]; }
            __syncthreads();
            if (F.tid < 480) { const int r = F.tid / 96, n = F.tid % 96; float s = bA[cb * 96 + n];
#pragma unroll
                for (int w = 0; w < 8; ++w) s += red[(w * 5 + r) * 96 + n];
                mod[(size_t)r * NT + cb * 96 + n] = s; }
            __syncthreads();
        }
        __syncthreads();
    }
}
__device__ __forceinline__ void p0_prologue(LAS unsigned char* lds_, const Params& p) {
    const Frame F = mk_frame(lds_);
    unsigned char* ws = p.ws;
    if (F.bid == 0) {
        float* tab = (float*)(ws + WS_ROPE);
        for (int i = F.tid; i < 2048; i += NTHR) { const int pos = i >> 5, j = i & 31;
            const float inv = exp2f(-(float)j * (13.287712379549449f / 32.0f));
            const float ang = (float)pos * inv; float f = ang * 0.15915494309189535f; f -= floorf(f);
            tab[2 * i] = __builtin_amdgcn_cosf(f); tab[2 * i + 1] = __builtin_amdgcn_sinf(f); }
    }
    { v4u* z = (v4u*)(ws + WS_WIN + (size_t)IN_COLS * D * 2); const size_t n = (size_t)(IN_PAD - IN_COLS) * D * 2 / 16;
      for (size_t i = (size_t)F.bid * NTHR + F.tid; i < n; i += (size_t)F.G * NTHR) z[i] = (v4u){0u, 0u, 0u, 0u}; }
    {
        LAS float* scr = (LAS float*)(F.lds + F.wave * 16896);
        const int gw = F.bid * NWAVES + F.wave, NGW = F.G * NWAVES;
        constexpr int NB_IN = 96 + 64 + 1;
        constexpr int I_IN = (D / 64) * NB_IN, I_O = (D / 64) * (D / 64), I_1 = (D / 64) * (FF / 64), I_2 = (FF / 64) * (D / 64);
        constexpr int NITEMS = I_IN + I_O + I_1 + I_2;
        bf16* WinT = (bf16*)(ws + WS_WIN); bf16* WoT = (bf16*)(ws + WS_WO); bf16* W1T = (bf16*)(ws + WS_W1); bf16* W2T = (bf16*)(ws + WS_W2);
        for (int it = gw; it < NITEMS; it += NGW) {
            int r = it;
            if (r < I_IN) { const int kb = r / NB_IN, nb = r % NB_IN;
                if (nb < 96) p0_transpose_item(p.in[I_WIN], D, IN_COLS, WinT, 64 * kb, 64 * nb, 64 * nb, scr, F.lane);
                else if (nb < 160) p0_transpose_item(p.in[I_WIN], D, IN_COLS, WinT, 64 * kb, C_SG + 64 * (nb - 96), C_LF + 64 * (nb - 96), scr, F.lane);
                else {
                    const float* W = p.in[I_WIN]; const int k0 = 64 * kb;
#pragma unroll 8
                    for (int i = 0; i < 32; ++i) { const int kk = 2 * i + (F.lane >> 5); scr[kk * 65 + (F.lane & 31)] = W[(size_t)(k0 + kk) * IN_COLS + C_LF + (F.lane & 31)]; }
                    LDS_WAIT(); asm volatile("" ::: "memory");
                    const int c = F.lane & 7;
#pragma unroll
                    for (int j = 0; j < 4; ++j) { const int n = (F.lane >> 3) + 8 * j; const LAS float* s2 = scr + (8 * c) * 65 + n;
                        v4u o; o.x = pk2(s2[0 * 65], s2[1 * 65]); o.y = pk2(s2[2 * 65], s2[3 * 65]); o.z = pk2(s2[4 * 65], s2[5 * 65]); o.w = pk2(s2[6 * 65], s2[7 * 65]);
                        *(v4u*)(WinT + (size_t)(IN_COLS - 32 + n) * D + k0 + 8 * c) = o; }
                    LDS_WAIT(); asm volatile("" ::: "memory");
                }
                continue; } r -= I_IN;
            if (r < I_O) { const int nbk = D / 64, kb = r / nbk, nb = r % nbk; p0_transpose_item(p.in[I_WO], D, D, WoT, 64 * kb, 64 * nb, 64 * nb, scr, F.lane); continue; } r -= I_O;
            if (r < I_1) { const int nbk = FF / 64, kb = r / nbk, nb = r % nbk; p0_transpose_item(p.in[I_W1], D, FF, W1T, 64 * kb, 64 * nb, 64 * nb, scr, F.lane); continue; } r -= I_1;
            { const int nbk = D / 64, kb = r / nbk, nb = r % nbk; p0_transpose_item(p.in[I_W2], FF, D, W2T, 64 * kb, 64 * nb, 64 * nb, scr, F.lane); }
        }
    }
}

__device__ __forceinline__ void p1_rows(LAS unsigned char* lds_, const Params& p) {
    const Frame F = mk_frame(lds_);
    LAS float* cA = (LAS float*)F.lds; LAS float* cB = cA + D;
    const float* mod = (const float*)(p.ws + WS_MOD); bf16* A1 = (bf16*)(p.ws + WS_A1);
    const int per = (MT + F.G - 1) / F.G; int r0 = F.bid * per; const int rend = (r0 + per < MT) ? r0 + per : MT;
    while (r0 < rend) {
        const int bb = r0 < M ? r0 / SEQ : 4; const int bend = r0 < M ? (bb + 1) * SEQ : MT; const int r1 = rend < bend ? rend : bend;
        __syncthreads();
        { float g_[8], sc_[8], sh_[8];
#pragma unroll
          for (int j = 0; j < 8; ++j) { const int c = F.tid + NTHR * j; g_[j] = p.in[I_PRE1][c]; sc_[j] = mod[(size_t)bb * NMOD * D + D + c]; sh_[j] = mod[(size_t)bb * NMOD * D + c]; }
#pragma unroll
          for (int j = 0; j < 8; ++j) { const int c = F.tid + NTHR * j; cA[c] = g_[j] * (1.0f + sc_[j]); cB[c] = sh_[j]; } }
        __syncthreads();
        f32x4 v[16], vn[16];
#define P1_LD(Vv, r_) do { const float* xr_ = (r_) < M ? p.in[I_X] + (size_t)(r_) * D : p.in[I_CTX] + (size_t)((r_) - M) * D; \
            _Pragma("unroll") for (int j = 0; j < 16; ++j) Vv[j] = __builtin_nontemporal_load((const f32x4*)(xr_ + 256 * j + 4 * F.lane)); } while (0)
        if (r0 + F.wave < r1) P1_LD(vn, r0 + F.wave);
        for (int r = r0 + F.wave; r < r1; r += NWAVES) {
#pragma unroll
            for (int j = 0; j < 16; ++j) v[j] = vn[j];
            if (r + NWAVES < r1) P1_LD(vn, r + NWAVES);
            float ss = 0.f;
#pragma unroll
            for (int j = 0; j < 16; ++j) ss += (v[j][0] * v[j][0] + v[j][1] * v[j][1]) + (v[j][2] * v[j][2] + v[j][3] * v[j][3]);
            const float rstd = rsqrtf(wave_sum(ss) * (1.0f / D) + EPS);
            bf16* orow = A1 + (size_t)r * D;
#pragma unroll
            for (int j = 0; j < 16; ++j) { const f32x4 a = *(LAS f32x4*)(cA + 256 * j + 4 * F.lane), b = *(LAS f32x4*)(cB + 256 * j + 4 * F.lane); const f32x4 o = v[j] * rstd * a + b;
                v2u w; w.x = pk2(o[0], o[1]); w.y = pk2(o[2], o[3]); st_global_b64(orow + 256 * j + 4 * F.lane, w); }
        }
#undef P1_LD
        r0 = r1;
    }
    __syncthreads();
}

__device__ __forceinline__ bf16x8 ldfrag(const LAS unsigned char* base, int row, int stride, int kbyte) { return *(const LAS bf16x8*)(base + row * stride + kbyte); }
__device__ __forceinline__ void p3_sg(LAS unsigned char* lds_, const Params& p) {
    const Frame F = mk_frame(lds_);
    constexpr int WS_OFF = 0, VN_OFF = 34816, ST_OFF = 69632, STR = 272;
    const bf16* VV = (const bf16*)(p.ws + WS_VV); const bf16* U = (const bf16*)(p.ws + WS_U); bf16* Y = (bf16*)(p.ws + WS_Y); const float* sgstat = (const float*)(p.ws + WS_SGSTAT);
    const int l15 = F.lane & 15, lq = F.lane >> 4;
    constexpr int NUNITS = SGG * BATCH * (SEQ / SGC) * 4;
    int u0, u1; { const int nt = (F.G > pg8::N_TAIL) ? pg8::N_TAIL : 0, nf = F.G - nt; int lo = (NUNITS - 10 * nf) / F.G; if (lo < 0 || nt == 0) lo = 0; int hi = nf > 0 ? (NUNITS - lo * nt + nf - 1) / nf : 0;
        if (nt == 0) { hi = (NUNITS + F.G - 1) / F.G; }
        if (F.bid >= nt) { u0 = (F.bid - nt) * hi; u1 = u0 + hi; } else { u0 = nf * hi + F.bid * lo; u1 = u0 + lo; }
        if (u0 > NUNITS) u0 = NUNITS; if (u1 > NUNITS) u1 = NUNITS;
        if (nt > 0 && F.bid == nt - 1) u1 = NUNITS; }
    int gcur = -1;
    bf16x8 Iev, Iod; { const int ie = l15 - 8 * lq, io = 16 + l15 - 8 * lq; unsigned iev[4] = {0u, 0u, 0u, 0u}, iod[4] = {0u, 0u, 0u, 0u};
#pragma unroll
        for (int e = 0; e < 8; ++e) { if (ie == e) iev[e >> 1] = (e & 1) ? 0x3F800000u : 0x00003F80u; if (io == e) iod[e >> 1] = (e & 1) ? 0x3F800000u : 0x00003F80u; }
        Iev = __builtin_bit_cast(bf16x8, (v4u){iev[0], iev[1], iev[2], iev[3]}); Iod = __builtin_bit_cast(bf16x8, (v4u){iod[0], iod[1], iod[2], iod[3]}); }
    struct SgRegs { v4u av[4]; f32x4 st[4]; v2u uu[8]; float lg[8], lb[8]; };
#define SG_DECODE(un_) const int g_ = (un_) / 512, rem_ = (un_) % 512, b_ = rem_ / 128, n_ = (rem_ % 128) / 4, cs_ = rem_ % 4; const int row0_ = b_ * SEQ + n_ * SGC, ch0_ = g_ * SGGW + cs_ * 128;
#define SG_LOAD(R, un_) do { SG_DECODE(un_) \
        _Pragma("unroll") for (int ks = 0; ks < 4; ++ks) R.av[ks] = *(const v4u*)(VV + (size_t)(row0_ + 16 * F.wave + l15) * SGW + ch0_ + 32 * ks + 8 * lq); \
        _Pragma("unroll") for (int k = 0; k < 4; ++k) R.st[k] = *(const f32x4*)(sgstat + (size_t)(row0_ + (F.tid >> 2)) * 64 + (F.tid & 3) * 16 + 4 * k); \
        _Pragma("unroll") for (int ti = 0; ti < 8; ++ti) R.uu[ti] = *(const v2u*)(U + (size_t)(row0_ + 16 * ti + l15) * SGW + ch0_ + 16 * F.wave + 4 * lq); \
        _Pragma("unroll") for (int ks = 0; ks < 4; ++ks) { R.lg[2 * ks] = p.in[I_SGLG][ch0_ + 32 * ks + l15]; R.lb[2 * ks] = p.in[I_SGLB][ch0_ + 32 * ks + l15]; R.lg[2 * ks + 1] = p.in[I_SGLG][ch0_ + 32 * ks + 16 + l15]; R.lb[2 * ks + 1] = p.in[I_SGLB][ch0_ + 32 * ks + 16 + l15]; } } while (0)
    SgRegs R, Rn; float bsv[8] = {0.f, 0.f, 0.f, 0.f, 0.f, 0.f, 0.f, 0.f};
    if (u0 < u1) SG_LOAD(Rn, u0);
    for (int un = u0; un < u1; ++un) {
        SG_DECODE(un) const int g = g_, row0 = row0_, ch0 = ch0_;
        R = Rn;
        if (un + 1 < u1) SG_LOAD(Rn, un + 1);
        LDS_BARRIER();
        if (g != gcur) { gcur = g; const float* W = p.in[I_WS] + (size_t)g * SGC * SGC;
#pragma unroll
            for (int ti = 0; ti < 8; ++ti) bsv[ti] = p.in[I_BS][g * SGC + 16 * ti + l15];
            f32x4 wv[8];
#pragma unroll
            for (int j = 0; j < 8; ++j) { const int i = F.tid + NTHR * j; wv[j] = *(const f32x4*)(W + (i / 32) * SGC + (i % 32) * 4); }
#pragma unroll
            for (int j = 0; j < 8; ++j) { const int i = F.tid + NTHR * j, r = i / 32, c4 = (i % 32) * 4; *(LAS v2u*)(F.lds + WS_OFF + r * STR + c4 * 2) = (v2u){pk2(wv[j][0], wv[j][1]), pk2(wv[j][2], wv[j][3])}; } }
        { const int row = F.tid >> 2, part = F.tid & 3; float s1 = 0.f, s2 = 0.f;
#pragma unroll
          for (int k = 0; k < 4; ++k) { s1 += R.st[k][0] + R.st[k][2]; s2 += R.st[k][1] + R.st[k][3]; }
          s1 += __shfl_xor(s1, 1); s2 += __shfl_xor(s2, 1); s1 += __shfl_xor(s1, 2); s2 += __shfl_xor(s2, 2);
          if (part == 0) { const float mu = s1 * (1.0f / SGW), var = s2 * (1.0f / SGW) - mu * mu; *(LAS f32x2*)(F.lds + ST_OFF + row * 8) = (f32x2){mu, rsqrtf(var + EPS)}; } }
        LDS_BARRIER();
        { const int tm = F.wave; const f32x4 stA = *(const LAS f32x4*)(F.lds + ST_OFF + (16 * tm + 4 * lq) * 8), stB = *(const LAS f32x4*)(F.lds + ST_OFF + (16 * tm + 4 * lq + 2) * 8);
          const float mu[4] = {stA[0], stA[2], stB[0], stB[2]}, rs[4] = {stA[1], stA[3], stB[1], stB[3]};
#pragma unroll
          for (int ks = 0; ks < 4; ++ks) { const f32x4 z = (f32x4){0.f, 0.f, 0.f, 0.f}; const bf16x8 a = __builtin_bit_cast(bf16x8, R.av[ks]);
              const f32x4 d0 = __builtin_amdgcn_mfma_f32_16x16x32_bf16(a, Iev, z, 0, 0, 0), d1 = __builtin_amdgcn_mfma_f32_16x16x32_bf16(a, Iod, z, 0, 0, 0);
              const int ca = 32 * ks + l15, cb = ca + 16; const float ga = R.lg[2 * ks], ba = R.lb[2 * ks], gb = R.lg[2 * ks + 1], bb = R.lb[2 * ks + 1];
              float ya[4], yb[4];
#pragma unroll
              for (int r = 0; r < 4; ++r) { ya[r] = (d0[r] - mu[r]) * rs[r] * ga + ba; yb[r] = (d1[r] - mu[r]) * rs[r] * gb + bb; }
              *(LAS v2u*)(F.lds + VN_OFF + ca * STR + (16 * tm + 4 * lq) * 2) = (v2u){pk2(ya[0], ya[1]), pk2(ya[2], ya[3])};
              *(LAS v2u*)(F.lds + VN_OFF + cb * STR + (16 * tm + 4 * lq) * 2) = (v2u){pk2(yb[0], yb[1]), pk2(yb[2], yb[3])}; } }
        LDS_BARRIER();
        f32x4 acc[8];
#pragma unroll
        for (int ti = 0; ti < 8; ++ti) acc[ti] = (f32x4){0.f, 0.f, 0.f, 0.f};
#pragma unroll
        for (int ks = 0; ks < 4; ++ks) { const bf16x8 a = ldfrag(F.lds + VN_OFF, 16 * F.wave + l15, STR, (8 * lq + 32 * ks) * 2);
#pragma unroll
            for (int ti = 0; ti < 8; ++ti) { const bf16x8 bb = ldfrag(F.lds + WS_OFF, 16 * ti + l15, STR, (8 * lq + 32 * ks) * 2); acc[ti] = __builtin_amdgcn_mfma_f32_16x16x32_bf16(a, bb, acc[ti], 0, 0, 0); } }
#pragma unroll
        for (int ti = 0; ti < 8; ++ti) { const int i = 16 * ti + l15, c = 16 * F.wave + 4 * lq; const float bs = bsv[ti];
            const v2u uu = R.uu[ti];
            const float o0 = bf_lo(uu.x) * (acc[ti][0] + bs), o1 = bf_hi(uu.x) * (acc[ti][1] + bs), o2 = bf_lo(uu.y) * (acc[ti][2] + bs), o3 = bf_hi(uu.y) * (acc[ti][3] + bs);
            v2u w; w.x = pk2(o0, o1); w.y = pk2(o2, o3); st_global_b64(Y + (size_t)(row0 + i) * D + VALW + ch0 + c, w); }
    }
#undef SG_LOAD
#undef SG_DECODE
    __syncthreads();
}


constexpr int BL_QT = 0, BL_KH = 17408, BL_ATT = 35840, BL_EBL = 45056, BLOB = 46080, VTIMG = 36864, NCH = 68;
constexpr size_t WS_BLOB = WS_MIX;
constexpr size_t WS_VT = WS_BLOB + (size_t)BATCH * HEADS * 2 * NCH * BLOB;
constexpr size_t WS_END2 = WS_VT + (size_t)BATCH * HEADS * NCH * VTIMG;
__device__ __forceinline__ float dpp_swap1(float x) { return __builtin_bit_cast(float, __builtin_amdgcn_update_dpp(0, __builtin_bit_cast(int, x), 0xB1, 0xF, 0xF, true)); }
__device__ __forceinline__ float logsig16(float a) { return (fminf(a, 0.f) - __logf(1.0f + __expf(-fabsf(a)))) * (1.0f / 16.0f); }
__device__ __forceinline__ void p3_gla_pre(LAS unsigned char* lds_, const Params& p) {
    const Frame F = mk_frame(lds_);
    constexpr int KT = 46080, GT = 63488, VTI = 65536;
    constexpr int S128 = 272, S64 = 144;
    const bf16* Qg = (const bf16*)(p.ws + WS_Q); const bf16* Kg = (const bf16*)(p.ws + WS_KB); const bf16* Vg = (const bf16*)(p.ws + WS_V); const float* LRg = (const float*)(p.ws + WS_LR);
    const float* tab = (const float*)(p.ws + WS_ROPE);
    const int w = F.wave, lane = F.lane, l15 = lane & 15, lq = lane >> 4, tt = w & 3, chh = w >> 2;
    float csC[2][4], snC[2][4];
#pragma unroll
    for (int pp = 0; pp < 2; ++pp)
#pragma unroll
        for (int r = 0; r < 4; ++r) { const f32x2 t = *(const f32x2*)(tab + ((16 * tt + 4 * lq + r) * 32 + 16 * pp + l15) * 2); csC[pp][r] = t.x; snC[pp][r] = t.y; }
    bf16x8 Iev, Iod; { const int ie = l15 - 8 * lq, io = 16 + l15 - 8 * lq; unsigned iev[4] = {0u, 0u, 0u, 0u}, iod[4] = {0u, 0u, 0u, 0u};
#pragma unroll
        for (int e = 0; e < 8; ++e) { if (ie == e) iev[e >> 1] = (e & 1) ? 0x3F800000u : 0x00003F80u; if (io == e) iod[e >> 1] = (e & 1) ? 0x3F800000u : 0x00003F80u; }
        Iev = __builtin_bit_cast(bf16x8, (v4u){iev[0], iev[1], iev[2], iev[3]}); Iod = __builtin_bit_cast(bf16x8, (v4u){iod[0], iod[1], iod[2], iod[3]}); }
    constexpr int NLAT = BATCH * HEADS * 64, NCTX = BATCH * HEADS * 4;
    const int per = (NLAT + F.G - 1) / F.G;
    const int n_lat = (F.bid * per >= NLAT) ? 0 : ((NLAT - F.bid * per) < per ? (NLAT - F.bid * per) : per);
    const int n_ctx = F.bid < NCTX ? (NCTX - F.bid + F.G - 1) / F.G : 0, total = n_lat + n_ctx;
    struct PreRegs { v4u q[2], k[2]; f32x4 lr[4]; f32x2 rt[2]; };
#define PRE_DECODE(i_) int b_, h_, cidx_; if ((i_) < n_lat) { const int un_ = F.bid * per + (i_); b_ = un_ >> 9; h_ = (un_ >> 6) & 7; cidx_ = 4 + (un_ & 63); } else { const int un_ = F.bid + ((i_) - n_lat) * F.G; b_ = un_ >> 5; h_ = (un_ >> 2) & 7; cidx_ = un_ & 3; } \
        const bool ctx_ = cidx_ < 4; const size_t row0_ = ctx_ ? (size_t)(M + b_ * CTXL + cidx_ * 64) : (size_t)(b_ * SEQ + (cidx_ - 4) * 64);
#define PRE_LOAD(R, i_) do { PRE_DECODE(i_) const size_t rt_ = row0_ + 16 * tt + l15; \
        _Pragma("unroll") for (int ksl = 0; ksl < 2; ++ksl) { if (!ctx_) R.q[ksl] = *(const v4u*)(Qg + rt_ * KEYW + h_ * DK + 64 * chh + 32 * ksl + 8 * lq); R.k[ksl] = *(const v4u*)(Kg + rt_ * KEYW + h_ * DK + 64 * chh + 32 * ksl + 8 * lq); } \
        _Pragma("unroll") for (int pp_ = 0; pp_ < 2; ++pp_) R.rt[pp_] = *(const f32x2*)(tab + ((ctx_ ? 0 : cidx_ - 4) * 32 + 16 * pp_ + l15) * 2); \
        _Pragma("unroll") for (int d = 0; d < 2; ++d) { R.lr[2 * d] = *(const f32x4*)(LRg + rt_ * 32 + d * 16 + 8 * (lq & 1)); R.lr[2 * d + 1] = *(const f32x4*)(LRg + rt_ * 32 + d * 16 + 8 * (lq & 1) + 4); } } while (0)
    PreRegs R, Rn;
    if (total > 0) PRE_LOAD(Rn, 0);
    bf16x8 wdf[2][4]; float bias[2][4]; int hcur = -1;
#pragma unroll
    for (int d = 0; d < 2; ++d)
#pragma unroll
        for (int tq = 0; tq < 4; ++tq) { wdf[d][tq] = Iev; bias[d][tq] = 0.f; }
    for (int it = 0; it < total; ++it) {
        PRE_DECODE(it) const int b = b_, h = h_, cidx = cidx_; const bool ctx = ctx_; const int ch = ctx ? cidx : cidx - 4;
        R = Rn;
        if (it + 1 < total) PRE_LOAD(Rn, it + 1);
        if (h != hcur) { hcur = h;
#pragma unroll
            for (int d = 0; d < 2; ++d) { const float* wd = p.in[d ? I_WDB : I_WDF]; const float* bd = p.in[d ? I_BDB : I_BDF];
#pragma unroll
                for (int tq = 0; tq < 4; ++tq) { const int c = h * DK + 64 * chh + 16 * tq + l15; unsigned pk[4];
#pragma unroll
                    for (int e = 0; e < 8; e += 2) pk[e >> 1] = pk2(wd[(8 * (lq & 1) + e) * KEYW + c], wd[(8 * (lq & 1) + e + 1) * KEYW + c]);
                    wdf[d][tq] = __builtin_bit_cast(bf16x8, (v4u){pk[0], pk[1], pk[2], pk[3]}); bias[d][tq] = bd[c]; } } }
        LDS_BARRIER();
        const f32x4 z4 = (f32x4){0.f, 0.f, 0.f, 0.f};
        float qv[4][4], kv[4][4];
#pragma unroll
        for (int ksl = 0; ksl < 2; ++ksl) { const bf16x8 ak = __builtin_bit_cast(bf16x8, R.k[ksl]);
            const f32x4 k0 = __builtin_amdgcn_mfma_f32_16x16x32_bf16(ak, Iev, z4, 0, 0, 0), k1 = __builtin_amdgcn_mfma_f32_16x16x32_bf16(ak, Iod, z4, 0, 0, 0);
            f32x4 q0 = z4, q1 = z4; if (!ctx) { const bf16x8 aq = __builtin_bit_cast(bf16x8, R.q[ksl]); q0 = __builtin_amdgcn_mfma_f32_16x16x32_bf16(aq, Iev, z4, 0, 0, 0); q1 = __builtin_amdgcn_mfma_f32_16x16x32_bf16(aq, Iod, z4, 0, 0, 0); }
#pragma unroll
            for (int r = 0; r < 4; ++r) { kv[2 * ksl][r] = k0[r]; kv[2 * ksl + 1][r] = k1[r]; qv[2 * ksl][r] = q0[r]; qv[2 * ksl + 1][r] = q1[r]; } }
        if (!ctx) {
#pragma unroll
            for (int pp = 0; pp < 2; ++pp) { const float c0 = R.rt[pp].x, s0 = R.rt[pp].y;
#pragma unroll
                for (int r = 0; r < 4; ++r) { const float cc = chh ? csC[pp][r] : c0, ss = chh ? snC[pp][r] : s0;
                    const float qa = qv[pp][r] * cc - qv[pp + 2][r] * ss, qb = qv[pp][r] * ss + qv[pp + 2][r] * cc; qv[pp][r] = qa; qv[pp + 2][r] = qb;
                    const float ka = kv[pp][r] * cc - kv[pp + 2][r] * ss, kb = kv[pp][r] * ss + kv[pp + 2][r] * cc; kv[pp][r] = ka; kv[pp + 2][r] = kb; } }
        }
#pragma unroll
        for (int dir = 0; dir < 2; ++dir) {
            bf16x8 afr; { const f32x4 l0 = R.lr[2 * dir], l1 = R.lr[2 * dir + 1];
                float x[8] = {l0[0], l0[1], l0[2], l0[3], l1[0], l1[1], l1[2], l1[3]}; unsigned pk[4];
#pragma unroll
                for (int e = 0; e < 8; e += 2) { float a0 = x[e], a1 = x[e + 1]; if (lq >= 2) { a0 -= bf_lo(pk2(a0, 0.f)); a1 -= bf_lo(pk2(a1, 0.f)); } pk[e >> 1] = pk2(a0, a1); }
                afr = __builtin_bit_cast(bf16x8, (v4u){pk[0], pk[1], pk[2], pk[3]}); }
            float cu[4][4];
#pragma unroll
            for (int tq = 0; tq < 4; ++tq) { const float bs = bias[dir][tq]; f32x4 a4 = (f32x4){bs, bs, bs, bs};
                a4 = __builtin_amdgcn_mfma_f32_16x16x32_bf16(afr, wdf[dir][tq], a4, 0, 0, 0);
#pragma unroll
                for (int r = 0; r < 4; ++r) cu[tq][r] = logsig16(a4[r]); }
#pragma unroll
            for (int tq = 0; tq < 4; ++tq) {
                if (!dir) { cu[tq][1] += cu[tq][0]; cu[tq][2] += cu[tq][1]; cu[tq][3] += cu[tq][2]; } else { cu[tq][2] += cu[tq][3]; cu[tq][1] += cu[tq][2]; cu[tq][0] += cu[tq][1]; }
                const float tl = dir ? cu[tq][0] : cu[tq][3]; float inc = tl;
                if (!dir) { float t = __shfl_up(inc, 16); if (lq >= 1) inc += t; t = __shfl_up(inc, 32); if (lq >= 2) inc += t; }
                else      { float t = __shfl_down(inc, 16); if (lq <= 2) inc += t; t = __shfl_down(inc, 32); if (lq <= 1) inc += t; }
                const float ex = inc - tl;
#pragma unroll
                for (int r = 0; r < 4; ++r) cu[tq][r] += ex;
                if (lq == (dir ? 0 : 3)) ((LAS float*)(F.lds + GT))[tt * DK + 64 * chh + 16 * tq + l15] = inc;
            }
            LDS_BARRIER();
#pragma unroll
            for (int tq = 0; tq < 4; ++tq) { const int c = 64 * chh + 16 * tq + l15; float off = 0.f, tot = 0.f;
#pragma unroll
                for (int t2 = 0; t2 < 4; ++t2) { const float g = ((const LAS float*)(F.lds + GT))[t2 * DK + c]; tot += g; if (dir ? (t2 > tt) : (t2 < tt)) off += g; }
                const float et = __expf(tot); if (tt == 0 && lq == 0) ((LAS float*)(F.lds + BL_EBL))[c] = et;
                float kh[4], qs[4], ks4[4];
#pragma unroll
                for (int r = 0; r < 4; ++r) { const float bq = cu[tq][r] + off, eb = __expf(bq), ei = __builtin_amdgcn_rcpf(eb);
                    const float kt = kv[tq][r] * ei; kh[r] = kt * et; ks4[r] = kt; qs[r] = qv[tq][r] * eb; }
                if (!ctx) {
                    const bool odd = l15 & 1; const int i0 = 16 * tt + 4 * lq + (odd ? 2 : 0), cd = (c & ~1) * 2;
                    const float q0 = dpp_swap1(odd ? qs[0] : qs[2]), q1 = dpp_swap1(odd ? qs[1] : qs[3]), k0 = dpp_swap1(odd ? ks4[0] : ks4[2]), k1 = dpp_swap1(odd ? ks4[1] : ks4[3]);
                    *(LAS unsigned*)(F.lds + BL_QT + i0 * S128 + cd) = odd ? pk2(q0, qs[2]) : pk2(qs[0], q0); *(LAS unsigned*)(F.lds + BL_QT + (i0 + 1) * S128 + cd) = odd ? pk2(q1, qs[3]) : pk2(qs[1], q1);
                    *(LAS unsigned*)(F.lds + KT + i0 * S128 + cd) = odd ? pk2(k0, ks4[2]) : pk2(ks4[0], k0); *(LAS unsigned*)(F.lds + KT + (i0 + 1) * S128 + cd) = odd ? pk2(k1, ks4[3]) : pk2(ks4[1], k1); }
                *(LAS v2u*)(F.lds + BL_KH + c * S64 + (16 * tt + 4 * lq) * 2) = (v2u){pk2(kh[0], kh[1]), pk2(kh[2], kh[3])}; }
            LDS_BARRIER();
            if (!ctx) {
                const int ti = w & 3;
#pragma unroll
                for (int t2 = 0; t2 < 2; ++t2) { const int tj = 2 * (w >> 2) + t2; f32x4 a4 = (f32x4){0.f, 0.f, 0.f, 0.f};
#pragma unroll
                    for (int ks = 0; ks < 4; ++ks) a4 = __builtin_amdgcn_mfma_f32_16x16x32_bf16(ldfrag(F.lds + KT, 16 * tj + l15, S128, (8 * lq + 32 * ks) * 2), ldfrag(F.lds + BL_QT, 16 * ti + l15, S128, (8 * lq + 32 * ks) * 2), a4, 0, 0, 0);
                    const int i = 16 * ti + l15, j0 = 16 * tj + 4 * lq; float m[4];
#pragma unroll
                    for (int r = 0; r < 4; ++r) { const int j = j0 + r; const bool keep = dir ? (j >= i) : (j <= i); m[r] = keep ? a4[r] : 0.f; }
                    *(LAS v2u*)(F.lds + BL_ATT + i * S64 + j0 * 2) = (v2u){pk2(m[0], m[1]), pk2(m[2], m[3])}; }
                LDS_BARRIER();
            }
            { unsigned char* bg = p.ws + WS_BLOB + ((size_t)((b * HEADS + h) * 2 + dir) * NCH + cidx) * BLOB;
              for (int i = F.tid; i < BLOB / 16; i += NTHR) st_global_b128(bg + i * 16, *(const LAS v4u*)(F.lds + i * 16));
            }
        }
    }
#undef PRE_LOAD
#undef PRE_DECODE
    __syncthreads();
}

__device__ __forceinline__ void p3_gla_scan(LAS unsigned char* lds_, const Params& p) {
    const Frame F = mk_frame(lds_);
    constexpr int BUFB = BLOB + 9216, ST0 = 2 * BUFB, STB = 17408, S128 = 272, S64 = 144;
    constexpr int NPIECE = BUFB / 1024;
    const int w = F.wave, lane = F.lane, l15 = lane & 15, lq = lane >> 4;
    const bf16* Vg = (const bf16*)(p.ws + WS_V);
    bf16x8 Iev, Iod; { const int ie = l15 - 8 * lq, io = 16 + l15 - 8 * lq; unsigned iev[4] = {0u, 0u, 0u, 0u}, iod[4] = {0u, 0u, 0u, 0u};
#pragma unroll
        for (int e = 0; e < 8; ++e) { if (ie == e) iev[e >> 1] = (e & 1) ? 0x3F800000u : 0x00003F80u; if (io == e) iod[e >> 1] = (e & 1) ? 0x3F800000u : 0x00003F80u; }
        Iev = __builtin_bit_cast(bf16x8, (v4u){iev[0], iev[1], iev[2], iev[3]}); Iod = __builtin_bit_cast(bf16x8, (v4u){iod[0], iod[1], iod[2], iod[3]}); }
    for (int un = F.bid; un < 256; un += F.G) {
        const int xcd = un & 7, slot = un >> 3, chain = xcd * 8 + (slot >> 2), dvs = slot & 3;
        const int b = chain >> 4, h = (chain >> 1) & 7, dir = chain & 1;
        bf16* Og = (bf16*)(p.ws + (dir ? WS_OB : WS_OF));
        const unsigned char* blobs = p.ws + WS_BLOB + (size_t)((b * HEADS + h) * 2 + dir) * NCH * BLOB;
        __syncthreads();
        for (int i = F.tid; i < STB / 4; i += NTHR) ((LAS unsigned*)(F.lds + ST0))[i] = 0u;
        f32x4 S[4];
#pragma unroll
        for (int tv = 0; tv < 4; ++tv) S[tv] = (f32x4){0.f, 0.f, 0.f, 0.f};
#define SCAN_CIDX(s) ((s) < 4 ? (dir ? 3 - (s) : (s)) : (dir ? 71 - (s) : (s)))
#define SCAN_ROW0(ci_) ((ci_) < 4 ? (size_t)(M + b * CTXL + (ci_) * 64) : (size_t)(b * SEQ + ((ci_) - 4) * 64))
#define SCAN_LD(R, s) do { const int ci_ = SCAN_CIDX(s); const unsigned char* bg_ = blobs + (size_t)ci_ * BLOB; \
            _Pragma("unroll") for (int j_ = 0; j_ < 6; ++j_) { const int q_ = F.tid + NTHR * j_; if (j_ < 5 || F.tid < 320) R[j_] = *(const v4u*)(bg_ + q_ * 16); } \
            R[6] = *(const v4u*)(Vg + (SCAN_ROW0(ci_) + 16 * (w & 3) + l15) * VALW + h * DV + dvs * 64 + 32 * (w >> 2) + 8 * lq); } while (0)
#define SCAN_ST(R, s) do { const int bo_ = ((s) & 1) * BUFB; \
            _Pragma("unroll") for (int j_ = 0; j_ < 6; ++j_) { const int q_ = F.tid + NTHR * j_; if (j_ < 5 || F.tid < 320) *(LAS v4u*)(F.lds + bo_ + q_ * 16) = R[j_]; } \
            { const bf16x8 a_ = __builtin_bit_cast(bf16x8, R[6]); const f32x4 z_ = (f32x4){0.f, 0.f, 0.f, 0.f}; \
              const f32x4 d0_ = __builtin_amdgcn_mfma_f32_16x16x32_bf16(a_, Iev, z_, 0, 0, 0), d1_ = __builtin_amdgcn_mfma_f32_16x16x32_bf16(a_, Iod, z_, 0, 0, 0); \
              LAS unsigned char* vt_ = F.lds + bo_ + BLOB + (32 * (w >> 2) + l15) * S64 + (16 * (w & 3) + 4 * lq) * 2; \
              *(LAS v2u*)vt_ = (v2u){pk2(d0_[0], d0_[1]), pk2(d0_[2], d0_[3])}; *(LAS v2u*)(vt_ + 16 * S64) = (v2u){pk2(d1_[0], d1_[1]), pk2(d1_[2], d1_[3])}; } } while (0)
        v4u RA[7], RB[7];
        SCAN_LD(RA, 0); SCAN_LD(RB, 1);
        SCAN_ST(RA, 0); SCAN_LD(RA, 2);
#pragma unroll 1
        for (int s2 = 0; s2 < NCH; s2 += 2) {
#pragma unroll
          for (int par = 0; par < 2; ++par) { const int s = s2 + par;
            const bool ctx = s < 4; const int ci = SCAN_CIDX(s); const int ch = ci - 4;
            const LAS unsigned char* buf = F.lds + (s & 1) * BUFB; const LAS unsigned char* vt = buf + BLOB;
            const LAS unsigned char* stc = F.lds + ST0 + (s & 1) * STB; LAS unsigned char* stn = F.lds + ST0 + ((s + 1) & 1) * STB;
            LDS_BARRIER();
            if (s + 1 < NCH) { if (par == 0) SCAN_ST(RB, s + 1); else SCAN_ST(RA, s + 1); }
            if (s + 3 < NCH) { if (par == 0) SCAN_LD(RB, s + 3); else SCAN_LD(RA, s + 3); }
            if (!ctx) {
                const int ti = w & 3; const size_t row0 = (size_t)(b * SEQ + ch * 64);
#pragma unroll
                for (int t2 = 0; t2 < 2; ++t2) { const int tv = 2 * (w >> 2) + t2; f32x4 o4 = (f32x4){0.f, 0.f, 0.f, 0.f};
#pragma unroll
                    for (int ks = 0; ks < 4; ++ks) o4 = __builtin_amdgcn_mfma_f32_16x16x32_bf16(ldfrag(stc, 16 * tv + l15, S128, (8 * lq + 32 * ks) * 2), ldfrag(buf + BL_QT, 16 * ti + l15, S128, (8 * lq + 32 * ks) * 2), o4, 0, 0, 0);
#pragma unroll
                    for (int ks = 0; ks < 2; ++ks) o4 = __builtin_amdgcn_mfma_f32_16x16x32_bf16(ldfrag(vt, 16 * tv + l15, S64, (8 * lq + 32 * ks) * 2), ldfrag(buf + BL_ATT, 16 * ti + l15, S64, (8 * lq + 32 * ks) * 2), o4, 0, 0, 0);
                    const int i = 16 * ti + l15, v0 = 16 * tv + 4 * lq;
                    st_global_b64(Og + (row0 + i) * VALW + h * DV + dvs * 64 + v0, (v2u){pk2(o4[0], o4[1]), pk2(o4[2], o4[3])}); }
            }
            { const f32x4 eb = *(const LAS f32x4*)(buf + BL_EBL + (16 * w + 4 * lq) * 4);
              const bf16x8 ka0 = ldfrag(buf + BL_KH, 16 * w + l15, S64, (8 * lq) * 2), ka1 = ldfrag(buf + BL_KH, 16 * w + l15, S64, (8 * lq + 32) * 2);
#pragma unroll
              for (int tv = 0; tv < 4; ++tv) { S[tv] = S[tv] * eb;
                  S[tv] = __builtin_amdgcn_mfma_f32_16x16x32_bf16(ka0, ldfrag(vt, 16 * tv + l15, S64, (8 * lq) * 2), S[tv], 0, 0, 0);
                  S[tv] = __builtin_amdgcn_mfma_f32_16x16x32_bf16(ka1, ldfrag(vt, 16 * tv + l15, S64, (8 * lq + 32) * 2), S[tv], 0, 0, 0);
                  *(LAS v2u*)(stn + (16 * tv + l15) * S128 + (16 * w + 4 * lq) * 2) = (v2u){pk2(S[tv][0], S[tv][1]), pk2(S[tv][2], S[tv][3])}; } }
          }
        }
#undef SCAN_LD
#undef SCAN_ST
#undef SCAN_ROW0
        asm volatile("s_waitcnt vmcnt(0)" ::: "memory");
#undef SCAN_CIDX
    }
    __syncthreads();
}

__device__ __forceinline__ void p4_readout(LAS unsigned char* lds_, const Params& p) {
    const Frame F = mk_frame(lds_);
    const bf16* OF = (const bf16*)(p.ws + WS_OF); const bf16* OB = (const bf16*)(p.ws + WS_OB); const bf16* SR = (const bf16*)(p.ws + WS_SR); bf16* Y = (bf16*)(p.ws + WS_Y);
    const int gw = F.bid * NWAVES + F.wave, NGW = F.G * NWAVES;
    f32x4 g[8];
#pragma unroll
    for (int h = 0; h < 8; ++h) g[h] = *(const f32x4*)(p.in[I_GNG] + h * DV + 4 * F.lane);
    for (int r = gw; r < M; r += NGW) {
        v2u a[8], b[8], c[8];
#pragma unroll
        for (int h = 0; h < 8; ++h) { const size_t o = (size_t)r * VALW + h * DV + 4 * F.lane; a[h] = __builtin_nontemporal_load((const v2u*)(OF + o)); b[h] = __builtin_nontemporal_load((const v2u*)(OB + o)); c[h] = __builtin_nontemporal_load((const v2u*)(SR + o)); }
#pragma unroll
        for (int h = 0; h < 8; ++h) {
            const float o0 = bf_lo(a[h].x) + bf_lo(b[h].x), o1 = bf_hi(a[h].x) + bf_hi(b[h].x), o2 = bf_lo(a[h].y) + bf_lo(b[h].y), o3 = bf_hi(a[h].y) + bf_hi(b[h].y);
            const float rstd = rsqrtf(wave_sum((o0 * o0 + o1 * o1) + (o2 * o2 + o3 * o3)) * (1.0f / DV) + EPS);
            v2u w; w.x = pk2(o0 * rstd * g[h][0] * bf_lo(c[h].x), o1 * rstd * g[h][1] * bf_hi(c[h].x)); w.y = pk2(o2 * rstd * g[h][2] * bf_lo(c[h].y), o3 * rstd * g[h][3] * bf_hi(c[h].y));
            *(v2u*)(Y + (size_t)r * D + h * DV + 4 * F.lane) = w; }
    }
}

__device__ __forceinline__ void p6_rows(LAS unsigned char* lds_, const Params& p) {
    const Frame F = mk_frame(lds_);
    LAS float* cA = (LAS float*)F.lds; LAS float* cB = cA + D; LAS float* cC = cB + D;
    const float* mod = (const float*)(p.ws + WS_MOD); bf16* A1 = (bf16*)(p.ws + WS_A1); const bf16* MIX = (const bf16*)(p.ws + WS_MIX); const float* ssq = (const float*)(p.ws + WS_SSQ);
    const int per = (M + F.G - 1) / F.G; int r0 = F.bid * per; const int rend = (r0 + per < M) ? r0 + per : M;
    while (r0 < rend) {
        const int bb = r0 / SEQ; const int bend = (bb + 1) * SEQ; const int r1 = rend < bend ? rend : bend; const float* mb = mod + (size_t)bb * NMOD * D;
        __syncthreads();
        { float l_[8][5];
#pragma unroll
          for (int j = 0; j < 8; ++j) { const int c = F.tid + NTHR * j; l_[j][0] = mb[2 * D + c]; l_[j][1] = p.in[I_POST1][c]; l_[j][2] = p.in[I_PRE2][c]; l_[j][3] = mb[4 * D + c]; l_[j][4] = mb[3 * D + c]; }
#pragma unroll
          for (int j = 0; j < 8; ++j) { const int c = F.tid + NTHR * j; cA[c] = l_[j][0] * l_[j][1]; cB[c] = l_[j][2] * (1.0f + l_[j][3]); cC[c] = l_[j][4]; } }
        __syncthreads();
        for (int r = r0 + F.wave; r < r1; r += NWAVES) {
            const float rstd1 = rsqrtf(wave_sum(ssq[(size_t)r * 64 + F.lane]) * (1.0f / D) + EPS);
            const float* xr = p.in[I_X] + (size_t)r * D; const bf16* mr = MIX + (size_t)r * D; float* orow = p.out + (size_t)r * D;
            f32x4 v[16]; float ss = 0.f;
#pragma unroll
            for (int jg = 0; jg < 16; jg += 8) {
                v2u m2[8];
#pragma unroll
                for (int j = 0; j < 8; ++j) { v[jg + j] = __builtin_nontemporal_load((const f32x4*)(xr + 256 * (jg + j) + 4 * F.lane)); m2[j] = __builtin_nontemporal_load((const v2u*)(mr + 256 * (jg + j) + 4 * F.lane)); }
#pragma unroll
                for (int j = 0; j < 8; ++j) { const f32x4 a = *(LAS f32x4*)(cA + 256 * (jg + j) + 4 * F.lane);
                    const f32x4 mx = (f32x4){bf_lo(m2[j].x), bf_hi(m2[j].x), bf_lo(m2[j].y), bf_hi(m2[j].y)};
                    const f32x4 t = v[jg + j] + a * mx * rstd1; v[jg + j] = t; ss += (t[0] * t[0] + t[1] * t[1]) + (t[2] * t[2] + t[3] * t[3]);
                    *(f32x4*)(orow + 256 * (jg + j) + 4 * F.lane) = t; }
                asm volatile("" ::: "memory");
            }
            const float rstd2 = rsqrtf(wave_sum(ss) * (1.0f / D) + EPS);
            bf16* hrow = A1 + (size_t)r * D;
#pragma unroll
            for (int j = 0; j < 16; ++j) { const f32x4 b = *(LAS f32x4*)(cB + 256 * j + 4 * F.lane), c = *(LAS f32x4*)(cC + 256 * j + 4 * F.lane); const f32x4 o = v[j] * rstd2 * b + c;
                v2u w; w.x = pk2(o[0], o[1]); w.y = pk2(o[2], o[3]); *(v2u*)(hrow + 256 * j + 4 * F.lane) = w; if ((j & 3) == 3) asm volatile("" ::: "memory"); }
        }
        r0 = r1;
    }
    __syncthreads();
}
__device__ __forceinline__ void p9_rows(LAS unsigned char* lds_, const Params& p) {
    const Frame F = mk_frame(lds_);
    LAS float* cA = (LAS float*)F.lds;
    const float* mod = (const float*)(p.ws + WS_MOD); const bf16* MLP = (const bf16*)(p.ws + WS_MIX); const float* ssq = (const float*)(p.ws + WS_SSQ);
    const int per = (M + F.G - 1) / F.G; int r0 = F.bid * per; const int rend = (r0 + per < M) ? r0 + per : M;
    while (r0 < rend) {
        const int bb = r0 / SEQ; const int bend = (bb + 1) * SEQ; const int r1 = rend < bend ? rend : bend; const float* mb = mod + (size_t)bb * NMOD * D;
        __syncthreads();
        { float l_[8][2];
#pragma unroll
          for (int j = 0; j < 8; ++j) { const int c = F.tid + NTHR * j; l_[j][0] = mb[5 * D + c]; l_[j][1] = p.in[I_POST2][c]; }
#pragma unroll
          for (int j = 0; j < 8; ++j) { const int c = F.tid + NTHR * j; cA[c] = l_[j][0] * l_[j][1]; } }
        __syncthreads();
        for (int r = r0 + F.wave; r < r1; r += NWAVES) {
            const float rstd = rsqrtf(wave_sum(ssq[(size_t)r * 64 + F.lane]) * (1.0f / D) + EPS);
            const bf16* mr = MLP + (size_t)r * D; float* orow = p.out + (size_t)r * D;
#pragma unroll
            for (int j = 0; j < 16; ++j) { const f32x4 x = __builtin_nontemporal_load((const f32x4*)(orow + 256 * j + 4 * F.lane)); const v2u m2 = __builtin_nontemporal_load((const v2u*)(mr + 256 * j + 4 * F.lane)); const f32x4 a = *(LAS f32x4*)(cA + 256 * j + 4 * F.lane);
                const f32x4 mx = (f32x4){bf_lo(m2.x), bf_hi(m2.x), bf_lo(m2.y), bf_hi(m2.y)};
                *(f32x4*)(orow + 256 * j + 4 * F.lane) = x + a * mx * rstd; }
        }
        r0 = r1;
    }
}

__global__ void __launch_bounds__(NTHR, 2) dit_fwd(Params p) {
    extern __shared__ __attribute__((aligned(16))) unsigned char lds_raw[];
    LAS unsigned char* lds = (LAS unsigned char*)lds_raw; const int G = gridDim.x, bid = blockIdx.x;
    volatile LAS unsigned* MISC = (volatile LAS unsigned*)(lds + LDS_CTL_OFF);
    if (threadIdx.x < 64) MISC[threadIdx.x] = 0u;
    __syncthreads();
    gu32* ctl = (gu32*)(p.ws + WS_CTL);
    XcdBarrier bar = xcd_barrier_post((unsigned*)(ctl + CW_BAR), MISC + 8);
    unsigned char* ws = p.ws;

    p0_adaln(lds, p);
    p0_prologue(lds, p);
    xcd_barrier(bar);
    p1_rows(lds, p);
    xcd_barrier(bar);
    {
        pg8::Gemm g{(const pg8::bf16_t*)(ws + WS_A1), (const pg8::bf16_t*)(ws + WS_WIN), MT, IN_PAD, D};
        pg8::InOrder S{G, bid};
        pg8::EpiIn E{(pg8::bf16_t*)(ws + WS_Q), (pg8::bf16_t*)(ws + WS_KB), (pg8::bf16_t*)(ws + WS_V), (pg8::bf16_t*)(ws + WS_SR), (pg8::bf16_t*)(ws + WS_U), (pg8::bf16_t*)(ws + WS_VV), (float*)(ws + WS_LR), (float*)(ws + WS_SGSTAT), 0.08838834764831845f};
        pg8::gemm_phase<pg8::EpiIn, pg8::InOrder, true, true>(lds, g, S, E);
    }
    xcd_barrier(bar);
    {
        pg8::Gemm g{(const pg8::bf16_t*)(ws + WS_A1), (const pg8::bf16_t*)(ws + WS_WIN), MT, IN_PAD, D};
        pg8::TailOrder S{G, bid};
        pg8::EpiIn E{(pg8::bf16_t*)(ws + WS_Q), (pg8::bf16_t*)(ws + WS_KB), (pg8::bf16_t*)(ws + WS_V), (pg8::bf16_t*)(ws + WS_SR), (pg8::bf16_t*)(ws + WS_U), (pg8::bf16_t*)(ws + WS_VV), (float*)(ws + WS_LR), (float*)(ws + WS_SGSTAT), 0.08838834764831845f};
        pg8::gemm_phase<pg8::EpiIn, pg8::TailOrder, true, true>(lds, g, S, E);
    }
    p3_sg(lds, p);
    xcd_barrier(bar);
    p3_gla_pre(lds, p);
    xcd_barrier(bar);
    p3_gla_scan(lds, p);
    xcd_barrier(bar);
    p4_readout(lds, p);
    xcd_barrier(bar);
    {
        pg8::Gemm g{(const pg8::bf16_t*)(ws + WS_Y), (const pg8::bf16_t*)(ws + WS_WO), M, D, D};
        pg8::StaticOrder S; S.init(M, D, G, bid);
        pg8::EpiAct<0, 1> E{(pg8::bf16_t*)(ws + WS_MIX), D, (float*)(ws + WS_SSQ)};
        pg8::gemm_phase<pg8::EpiAct<0, 1>, pg8::StaticOrder, true, true>(lds, g, S, E);
    }
    xcd_barrier(bar);
    p6_rows(lds, p);
    xcd_barrier(bar);
    {
        pg8::Gemm g{(const pg8::bf16_t*)(ws + WS_A1), (const pg8::bf16_t*)(ws + WS_W1), M, FF, D};
        pg8::StaticOrder S; S.init(M, FF, G, bid);
        pg8::EpiAct<3, 0> E{(pg8::bf16_t*)(ws + WS_HMID), FF, nullptr};
        pg8::gemm_phase<pg8::EpiAct<3, 0>, pg8::StaticOrder, true, true>(lds, g, S, E);
    }
    xcd_barrier(bar);
    {
        pg8::Gemm g{(const pg8::bf16_t*)(ws + WS_HMID), (const pg8::bf16_t*)(ws + WS_W2), M, D, FF};
        pg8::StaticOrder S; S.init(M, D, G, bid);
        pg8::EpiAct<0, 1> E{(pg8::bf16_t*)(ws + WS_MIX), D, (float*)(ws + WS_SSQ)};
        pg8::gemm_phase<pg8::EpiAct<0, 1>, pg8::StaticOrder, true, true>(lds, g, S, E);
    }
    xcd_barrier(bar);
    p9_rows(lds, p);
}

extern "C" void kernel_launch(void* const* d_in, const int* in_sizes, int n_in, void* d_out, int out_size, void* d_ws, size_t ws_size, hipStream_t stream) {
    static int grid = 0;
    if (grid == 0) {
        if (n_in != 23 || in_sizes[0] != M * D || out_size != M * D || ws_size < WS_END2) { fprintf(stderr, "kernel_launch: unexpected shapes (n_in %d, in0 %d, out %d, ws %zu); nothing launched\n", n_in, n_in > 0 ? in_sizes[0] : -1, out_size, ws_size); grid = -1; return; }
        int dev = 0, cus = 0, per_cu = 0;
        if (hipGetDevice(&dev) != hipSuccess || hipDeviceGetAttribute(&cus, hipDeviceAttributeMultiprocessorCount, dev) != hipSuccess) { grid = -1; return; }
        if (hipFuncSetAttribute((const void*)dit_fwd, hipFuncAttributeMaxDynamicSharedMemorySize, LDS_BYTES) != hipSuccess) { fprintf(stderr, "kernel_launch: hipFuncSetAttribute failed\n"); grid = -1; return; }
        if (hipOccupancyMaxActiveBlocksPerMultiprocessor(&per_cu, (const void*)dit_fwd, NTHR, LDS_BYTES) != hipSuccess || per_cu < 1) { fprintf(stderr, "kernel_launch: occupancy query reports %d blocks per CU\n", per_cu); }
        (void)hipGetLastError();
        grid = cus;
    }
    if (grid < 0) return;
    if (hipMemsetAsync((char*)d_ws + WS_CTL, 0, CTL_ZERO_BYTES, stream) != hipSuccess) return;
    Params a{};
    for (int i = 0; i < 23; ++i) a.in[i] = (const float*)d_in[i];
    a.out = (float*)d_out; a.ws = (unsigned char*)d_ws;
    hipLaunchKernelGGL(dit_fwd, dim3(grid), dim3(NTHR), LDS_BYTES, stream, a);
}
```

```cpp
#include <hip/hip_runtime.h>
#include <cstdio>
#include <cstdint>
namespace pg8 {
#define PG8_LAS __attribute__((address_space(3)))
typedef unsigned short bf16_t;
typedef short bf16x8 __attribute__((ext_vector_type(8)));
typedef float f32x4 __attribute__((ext_vector_type(4)));
typedef unsigned u32x4 __attribute__((ext_vector_type(4)));
constexpr int BM = 256, BK = 64, HALF = 128, HTB = HALF * BK * 2  , STAGE_BYTES = 8 * HTB, NXCD = 8, WGM = 8;

__host__ __device__ __forceinline__ int lds_byte(int r, int c) { const int st = (r >> 4) * 2 + (c >> 5), rr = r & 15, cc = c & 31, ob = rr * 64 + cc * 2; return st * 1024 + (ob ^ (((ob >> 9) & 1) << 5)); }
__host__ __device__ __forceinline__ void stage_rc(int b, int& R, int& C) { const int st = b / 1024, sb = b % 1024, swz = sb ^ (((sb >> 9) & 1) << 5); R = (st >> 1) * 16 + swz / 64; C = (st & 1) * 32 + (swz % 64) / 2; }
__host__ __device__ __forceinline__ int perm32(int rho) { const int n = rho >> 4, i = rho & 15; return 8 * (i >> 2) + 4 * n + (i & 3); }

struct Unit { int pm, pn; };
struct Gemm { const bf16_t* A; const bf16_t* Bt; int M, N, K; };

struct StaticOrder {
    int nM, nN, nwg, G, c;
    __host__ __device__ void init(int M, int N, int G_, int c_) { nM = M / BM; nN = N / BM; nwg = nM * nN; G = G_; c = c_; }
    __host__ __device__ bool next(int i, Unit& u) const {
        const long L = (long)i * G + c; if (L >= nwg) return false;
        int wgid = (int)L; { const int q = nwg / NXCD, r = nwg % NXCD, xcd = wgid % NXCD, off = wgid / NXCD; wgid = (xcd < r ? xcd * (q + 1) : r * (q + 1) + (xcd - r) * q) + off; }
        const int nig = WGM * nN, gid = wgid / nig, fm = gid * WGM, gsz = (nM - fm) < WGM ? (nM - fm) : WGM;
        u.pm = fm + ((wgid % nig) % gsz); u.pn = (wgid % nig) / gsz; return true;
    }
    __device__ __forceinline__ void a_ready(const Unit&) const {}
    __device__ __forceinline__ void done(const Unit&) const {}
};

__device__ __forceinline__ unsigned cvt_pk_bf16(float lo, float hi) { unsigned r; asm volatile("v_cvt_pk_bf16_f32 %0, %1, %2" : "=v"(r) : "v"(lo), "v"(hi)); return r; }
typedef float f32x2 __attribute__((ext_vector_type(2)));
__device__ __forceinline__ f32x2 gelu_pk(f32x2 v) {
    const f32x2 av = __builtin_elementwise_abs(v), d = av * 0.2316418882f + 1.0f;
    f32x2 t; t.x = __builtin_amdgcn_rcpf(d.x); t.y = __builtin_amdgcn_rcpf(d.y);
    f32x2 q = t * 0.5307027145f + (-0.7265760135f); q = q * t + 0.7107068705f; q = q * t + (-0.142248368f); q = q * t + 0.127414796f; q = q * t;
    const f32x2 s = (v * v) * (-0.72134752044f);
    f32x2 e; e.x = __builtin_amdgcn_exp2f(s.x); e.y = __builtin_amdgcn_exp2f(s.y);
    const f32x2 m = v * (q * e), r = v - m;
    f32x2 o; o.x = v.x < 0.f ? m.x : r.x; o.y = v.y < 0.f ? m.y : r.y; return o;
}

typedef unsigned u32x2 __attribute__((ext_vector_type(2)));
template <int ACT> __device__ __forceinline__ f32x4 act4(f32x4 v, float sc) {
    if (ACT == 0) return v * sc;
    if (ACT == 1) { f32x4 o;
#pragma unroll
        for (int j = 0; j < 4; ++j) o[j] = v[j] * __builtin_amdgcn_rcpf(1.0f + __expf(-v[j]));
        return o; }
    if (ACT == 2) { const f32x2 a = gelu_pk((f32x2){v[0], v[1]}), b = gelu_pk((f32x2){v[2], v[3]}); return (f32x4){a.x, a.y, b.x, b.y}; }
    { f32x4 o;
#pragma unroll
        for (int j = 0; j < 4; ++j) { const float t = v[j] > 0.f ? v[j] : 0.f; o[j] = t * t; }
        return o; }
}
template <int ACT, int STAT> __device__ __forceinline__ void store_tile(const f32x4 (&acc)[2][2][4][2], bf16_t* base, int ldc, int row0, int col0, float sc, float* stat, int slot, int fq) {
#pragma unroll
    for (int ai = 0; ai < 2; ++ai)
#pragma unroll
        for (int m = 0; m < 4; ++m) { const int row = row0 + ai * HALF + m * 16; bf16_t* rowp = base + (size_t)row * ldc + col0; float s1 = 0.f, s2 = 0.f;
#pragma unroll
            for (int bj = 0; bj < 2; ++bj) { const f32x4 v0 = act4<ACT>(acc[ai][bj][m][0], sc), v1 = act4<ACT>(acc[ai][bj][m][1], sc);
                if (STAT) { s1 += (v0[0] + v0[1]) + (v0[2] + v0[3]) + (v1[0] + v1[1]) + (v1[2] + v1[3]);
                            s2 += (v0[0] * v0[0] + v0[1] * v0[1]) + (v0[2] * v0[2] + v0[3] * v0[3]) + (v1[0] * v1[0] + v1[1] * v1[1]) + (v1[2] * v1[2] + v1[3] * v1[3]); }
                u32x4 w; w.x = cvt_pk_bf16(v0[0], v0[1]); w.y = cvt_pk_bf16(v0[2], v0[3]); w.z = cvt_pk_bf16(v1[0], v1[1]); w.w = cvt_pk_bf16(v1[2], v1[3]);
                *(u32x4*)(rowp + bj * HALF) = w; }
            if (STAT) { s2 += __shfl_xor(s2, 16); s2 += __shfl_xor(s2, 32);
                if (STAT == 2) { s1 += __shfl_xor(s1, 16); s1 += __shfl_xor(s1, 32); if (fq == 0) *(f32x2*)(stat + ((size_t)row * 32 + slot) * 2) = (f32x2){s1, s2}; }
                else { if (fq == 0) stat[(size_t)row * 64 + slot] = s2; } } }
}
struct EpiIn {
    static constexpr bool PERM = true, AFTER_DRAIN = false;
    bf16_t *Q, *Kb, *V, *SR, *U, *VV; float* LR; float* sgstat; float qscale;
    __device__ __forceinline__ void operator()(const f32x4 (&acc)[2][2][4][2], const Unit& u, int wr, int wc, int fr, int fq) const {
        const int pn = u.pn, row0 = u.pm * BM + wr * 64 + fr, cw = wc * 32 + 8 * fq;
        if (pn < 4)       store_tile<0, 0>(acc, Q, 1024, row0, pn * 256 + cw, qscale, nullptr, 0, fq);
        else if (pn < 8)  store_tile<0, 0>(acc, Kb, 1024, row0, (pn - 4) * 256 + cw, 1.0f, nullptr, 0, fq);
        else if (pn < 16) store_tile<0, 0>(acc, V, 2048, row0, (pn - 8) * 256 + cw, 1.0f, nullptr, 0, fq);
        else if (pn < 24) store_tile<1, 0>(acc, SR, 2048, row0, (pn - 16) * 256 + cw, 1.0f, nullptr, 0, fq);
        else if (pn < 32) store_tile<2, 0>(acc, U, 2048, row0, (pn - 24) * 256 + cw, 1.0f, nullptr, 0, fq);
        else if (pn < 40) store_tile<2, 2>(acc, VV, 2048, row0, (pn - 32) * 256 + cw, 1.0f, sgstat, (pn - 32) * 4 + wc, fq);
        else if (wc == 0) {
#pragma unroll
            for (int ai = 0; ai < 2; ++ai)
#pragma unroll
                for (int m = 0; m < 4; ++m) { float* p = LR + (size_t)(row0 + ai * HALF + m * 16) * 32 + 8 * fq; *(f32x4*)p = acc[ai][0][m][0]; *(f32x4*)(p + 4) = acc[ai][0][m][1]; }
        }
    }
};
struct InOrder {
    int G, c;
    __device__ bool next(int i, Unit& u) const {
        const int L = i * G + c; constexpr int nM = 64, nN = 40, nwg = nM * nN;
        if (L >= nwg) return false;
        int wgid = L; { const int q = nwg / NXCD, xcd = wgid % NXCD, off = wgid / NXCD; wgid = xcd * q + off; }
        const int nig = WGM * nN, gid = wgid / nig, fm = gid * WGM;
        u.pm = fm + ((wgid % nig) % WGM); u.pn = (wgid % nig) / WGM; return true;
    }
    __device__ __forceinline__ void a_ready(const Unit&) const {}
    __device__ __forceinline__ void done(const Unit&) const {}
};
constexpr int N_TAIL = 116;
struct TailOrder {
    int G, c;
    __device__ bool next(int i, Unit& u) const {
        const int L = i * G + c; if (L >= N_TAIL) return false;
        if (L < 68) { u.pm = L; u.pn = 40; } else { const int x = L - 68; u.pm = 64 + x / 12; u.pn = 4 + x % 12; }
        return true;
    }
    __device__ __forceinline__ void a_ready(const Unit&) const {}
    __device__ __forceinline__ void done(const Unit&) const {}
};
template <int ACT, int STAT> struct EpiAct {
    static constexpr bool PERM = true, AFTER_DRAIN = false;
    bf16_t* O; int ldc; float* stat;
    __device__ __forceinline__ void operator()(const f32x4 (&acc)[2][2][4][2], const Unit& u, int wr, int wc, int fr, int fq) const {
        store_tile<ACT, STAT>(acc, O, ldc, u.pm * BM + wr * 64 + fr, u.pn * BM + wc * 32 + 8 * fq, 1.0f, stat, u.pn * 4 + wc, fq);
    }
};
template <class Epi, class Sched, bool ALIGN_EPI = false, bool SP2 = false>
__device__ __forceinline__ void gemm_phase(PG8_LAS unsigned char* lds, const Gemm g, const Sched& S, const Epi& E) {
    int tid_ = threadIdx.x; asm volatile("" : "+v"(tid_));
    const int tid = tid_, wid = __builtin_amdgcn_readfirstlane(tid >> 6), lane = tid & 63, wr = wid >> 2, wc = wid & 3, fr = lane & 15, fq = lane >> 4;
    const int K = g.K, nt = K / BK;
    unsigned voffA[2], voffB[2];
#pragma unroll
    for (int i = 0; i < 2; ++i) { int R, C; stage_rc(tid * 16 + i * 8192, R, C); const int Rb = Epi::PERM ? ((R & ~31) + perm32(R & 31)) : R;
        voffA[i] = (unsigned)(R * K + C) * 2u; voffB[i] = (unsigned)(Rb * K + C) * 2u; }
    const size_t kstep = (size_t)(BK * 2);
    const size_t hstep = (size_t)HALF * K * 2;
    const size_t tstep = 2 * hstep;
    const unsigned ldsw = (unsigned)wid * 1024u;
    const int aoff = lds_byte(wr * 64 + fr, fq * 8), boff = lds_byte(wc * 32 + fr, fq * 8);
#define PG8_SA(b, h) (((b) * 2 + (h)) * HTB)
#define PG8_SB(b, h) ((4 + (b) * 2 + (h)) * HTB)
#define PG8_STAGE(bufoff, gbase, voff) do { _Pragma("unroll") for (int _i = 0; _i < 2; ++_i) \
        __builtin_amdgcn_global_load_lds((const unsigned*)((const char*)(gbase) + (voff)[_i]), (PG8_LAS unsigned*)(lds + (bufoff) + ldsw + _i * 8192), 16, 0, 0); } while (0)
#define PG8_LDA(dst, b, h) do { _Pragma("unroll") for (int m = 0; m < 4; ++m) _Pragma("unroll") for (int k = 0; k < 2; ++k) dst[m][k] = *(const PG8_LAS bf16x8*)(lds + PG8_SA(b, h) + aoff + m * 2048 + k * 1024); } while (0)
#define PG8_LDB(dst, b, h) do { _Pragma("unroll") for (int n = 0; n < 2; ++n) _Pragma("unroll") for (int k = 0; k < 2; ++k) dst[n][k] = *(const PG8_LAS bf16x8*)(lds + PG8_SB(b, h) + boff + n * 2048 + k * 1024); } while (0)
#define PG8_MMA(ai, bj, At, Bt) do { __builtin_amdgcn_s_setprio(1); _Pragma("unroll") for (int m = 0; m < 4; ++m) _Pragma("unroll") for (int n = 0; n < 2; ++n) _Pragma("unroll") for (int k = 0; k < 2; ++k) \
        acc[ai][bj][m][n] = __builtin_amdgcn_mfma_f32_16x16x32_bf16(Bt[n][k], At[m][k], acc[ai][bj][m][n], 0, 0, 0); __builtin_amdgcn_s_setprio(0); } while (0)
#define PG8_WAIT_V(n) asm volatile("s_waitcnt vmcnt(" #n ")" ::: "memory")
#define PG8_WAIT_L(n) asm volatile("s_waitcnt lgkmcnt(" #n ")" ::: "memory")
#define PG8_BAR __builtin_amdgcn_s_barrier()
#define PG8_SCHED __builtin_amdgcn_sched_barrier(0)
    Unit cur, nxt; int ui = 0;
    if (!S.next(0, cur)) return;
    f32x4 acc[2][2][4][2];
#pragma unroll
    for (int a = 0; a < 2; ++a)
#pragma unroll
        for (int b = 0; b < 2; ++b)
#pragma unroll
            for (int m = 0; m < 4; ++m)
#pragma unroll
                for (int n = 0; n < 2; ++n) acc[a][b][m][n] = (f32x4){0.f, 0.f, 0.f, 0.f};
    bf16x8 At[4][2], B0[2][2], B1[2][2];
    const char* cA = (const char*)g.A + (size_t)cur.pm * tstep; const char* cB = (const char*)g.Bt + (size_t)cur.pn * tstep;
    S.a_ready(cur);
    if constexpr (SP2) {
        PG8_STAGE(PG8_SB(0, 0), cB, voffB); PG8_STAGE(PG8_SB(0, 1), cB + hstep, voffB); PG8_STAGE(PG8_SA(0, 0), cA, voffA); PG8_STAGE(PG8_SA(0, 1), cA + hstep, voffA);
        if (wr == 1) PG8_BAR;
        PG8_WAIT_V(2); PG8_BAR;
        PG8_STAGE(PG8_SB(1, 0), cB + kstep, voffB); PG8_STAGE(PG8_SA(1, 0), cA + kstep, voffA); PG8_STAGE(PG8_SB(1, 1), cB + hstep + kstep, voffB);
        PG8_WAIT_V(6); PG8_BAR;
    } else {
        PG8_STAGE(PG8_SB(0, 0), cB, voffB); PG8_STAGE(PG8_SA(0, 0), cA, voffA); PG8_STAGE(PG8_SB(0, 1), cB + hstep, voffB); PG8_STAGE(PG8_SA(0, 1), cA + hstep, voffA);
        if (wr == 1) PG8_BAR;
        PG8_WAIT_V(4); PG8_BAR;
        PG8_STAGE(PG8_SB(1, 0), cB + kstep, voffB); PG8_STAGE(PG8_SA(1, 0), cA + kstep, voffA); PG8_STAGE(PG8_SB(1, 1), cB + hstep + kstep, voffB);
        PG8_WAIT_V(6); PG8_BAR;
    }
    for (;;) {
        const bool has_next = S.next(ui + 1, nxt);
        const char* nA = has_next ? (const char*)g.A + (size_t)nxt.pm * tstep : cA; const char* nB = has_next ? (const char*)g.Bt + (size_t)nxt.pn * tstep : cB;
        for (int t = 0; t < nt; t += 2) {
            const bool last = (t == nt - 2);
            const char* a1 = cA + (size_t)(t + 1) * kstep;
            const char* a2 = last ? nA : cA + (size_t)(t + 2) * kstep; const char* b2 = last ? nB : cB + (size_t)(t + 2) * kstep;
            const char* a3 = a2 + kstep; const char* b3 = b2 + kstep;
            if (last && has_next) S.a_ready(nxt);
            if constexpr (SP2) {
            PG8_LDB(B0, 0, 0); PG8_LDB(B1, 0, 1); PG8_SCHED; PG8_LDA(At, 0, 0); PG8_STAGE(PG8_SA(1, 1), a1 + hstep, voffA);
            PG8_WAIT_V(8); PG8_WAIT_L(0); PG8_BAR; PG8_MMA(0, 0, At, B0); PG8_MMA(0, 1, At, B1); PG8_BAR; PG8_SCHED;
            PG8_LDA(At, 0, 1); PG8_STAGE(PG8_SB(0, 0), b2, voffB); PG8_STAGE(PG8_SB(0, 1), b2 + hstep, voffB); PG8_STAGE(PG8_SA(0, 0), a2, voffA);
            PG8_WAIT_V(8); PG8_WAIT_L(0); PG8_BAR; PG8_MMA(1, 0, At, B0); PG8_MMA(1, 1, At, B1); PG8_BAR; PG8_SCHED;
            PG8_LDB(B0, 1, 0); PG8_LDB(B1, 1, 1); PG8_SCHED; PG8_LDA(At, 1, 0); PG8_STAGE(PG8_SA(0, 1), a2 + hstep, voffA);
            PG8_WAIT_V(8); PG8_WAIT_L(0); PG8_BAR; PG8_MMA(0, 0, At, B0); PG8_MMA(0, 1, At, B1); PG8_BAR; PG8_SCHED;
            PG8_LDA(At, 1, 1); PG8_STAGE(PG8_SB(1, 0), b3, voffB); PG8_STAGE(PG8_SB(1, 1), b3 + hstep, voffB); PG8_STAGE(PG8_SA(1, 0), a3, voffA);
            PG8_WAIT_V(8); PG8_WAIT_L(0); PG8_BAR; PG8_MMA(1, 0, At, B0); PG8_MMA(1, 1, At, B1); PG8_BAR; PG8_SCHED;
            } else {
            PG8_LDB(B0, 0, 0); PG8_SCHED; PG8_LDA(At, 0, 0); PG8_STAGE(PG8_SA(1, 1), a1 + hstep, voffA);
            PG8_WAIT_L(8); PG8_BAR; PG8_WAIT_L(0); PG8_MMA(0, 0, At, B0); PG8_BAR; PG8_SCHED;
            PG8_LDB(B1, 0, 1); PG8_STAGE(PG8_SB(0, 0), b2, voffB);
            PG8_BAR; PG8_WAIT_L(0); PG8_MMA(0, 1, At, B1); PG8_BAR;
            PG8_LDA(At, 0, 1); PG8_STAGE(PG8_SA(0, 0), a2, voffA);
            PG8_BAR; PG8_WAIT_L(0); PG8_MMA(1, 0, At, B0); PG8_BAR; PG8_SCHED;
            PG8_STAGE(PG8_SB(0, 1), b2 + hstep, voffB);
            PG8_WAIT_V(6); PG8_BAR; PG8_MMA(1, 1, At, B1); PG8_BAR;
            PG8_LDB(B0, 1, 0); PG8_SCHED; PG8_LDA(At, 1, 0); PG8_STAGE(PG8_SA(0, 1), a2 + hstep, voffA);
            PG8_WAIT_L(8); PG8_BAR; PG8_WAIT_L(0); PG8_MMA(0, 0, At, B0); PG8_BAR; PG8_SCHED;
            PG8_LDB(B1, 1, 1); PG8_STAGE(PG8_SB(1, 0), b3, voffB);
            PG8_BAR; PG8_WAIT_L(0); PG8_MMA(0, 1, At, B1); PG8_BAR;
            PG8_LDA(At, 1, 1); PG8_STAGE(PG8_SA(1, 0), a3, voffA);
            PG8_BAR; PG8_WAIT_L(0); PG8_MMA(1, 0, At, B0); PG8_BAR; PG8_SCHED;
            PG8_STAGE(PG8_SB(1, 1), b3 + hstep, voffB);
            PG8_WAIT_V(6); PG8_BAR; PG8_MMA(1, 1, At, B1); PG8_BAR;
            }
        }
        if constexpr (ALIGN_EPI) { if (wr == 0) PG8_BAR; }
        if constexpr (!Epi::AFTER_DRAIN) { E(acc, cur, wr, wc, fr, fq); S.done(cur); }
        if (!has_next) break;
#pragma unroll
        for (int a = 0; a < 2; ++a)
#pragma unroll
            for (int b = 0; b < 2; ++b)
#pragma unroll
                for (int m = 0; m < 4; ++m)
#pragma unroll
                    for (int n = 0; n < 2; ++n) acc[a][b][m][n] = (f32x4){0.f, 0.f, 0.f, 0.f};
        cur = nxt; cA = nA; cB = nB; ++ui;
        if constexpr (ALIGN_EPI) { if (wr == 1) PG8_BAR; }
    }
    PG8_WAIT_V(0);
    if constexpr (!ALIGN_EPI) { if (wr == 0) PG8_BAR; }
    PG8_BAR;
    if constexpr (Epi::AFTER_DRAIN) { E.fused(acc, cur, wr, wc, fr, fq, lds, wid, lane); S.done(cur); }
#undef PG8_SA
#undef PG8_SB
#undef PG8_STAGE
#undef PG8_LDA
#undef PG8_LDB
#undef PG8_MMA
#undef PG8_WAIT_V
#undef PG8_WAIT_L
#undef PG8_BAR
#undef PG8_SCHED
}
}

constexpr int NWAVES = 8, NTHR = 512;
constexpr int BATCH = 4, SEQ = 4096, D = 4096, CTXL = 256, M = BATCH * SEQ, MC = BATCH * CTXL, MT = M + MC;
constexpr int HEADS = 8, DK = 128, DV = 256, KEYW = 1024, VALW = 2048, LOWR = 16, SGW = 2048, SGG = 4, SGGW = 512, SGC = 128, FF = 16384, NMOD = 6;
constexpr int IN_COLS = 10272, IN_PAD = 10496;
constexpr int C_LF = 6144, C_SG = 6176;
constexpr float EPS = 1e-6f;

constexpr size_t MiB = 1u << 20;
constexpr size_t WS_CTL = 0, CTL_ZERO_BYTES = 64 * 1024;
constexpr size_t WS_MOD = 1 * MiB;
constexpr size_t WS_ROPE = 2 * MiB;
constexpr size_t WS_SGSTAT = 3 * MiB;
constexpr size_t WS_SSQ = 7 * MiB, WS_SSQ2 = 11 * MiB;
constexpr size_t WS_WIN = 16 * MiB, WS_WO = 98 * MiB, WS_W1 = 130 * MiB, WS_W2 = 258 * MiB;
constexpr size_t WS_A1 = 386 * MiB;
constexpr size_t WS_Q = 522 * MiB, WS_KB = 554 * MiB, WS_V = 588 * MiB, WS_SR = 656 * MiB, WS_U = 720 * MiB, WS_VV = 784 * MiB, WS_LR = 848 * MiB, WS_OF = 851 * MiB, WS_OB = 915 * MiB, WS_Y = 979 * MiB;
constexpr size_t WS_HMID = 522 * MiB;
constexpr size_t WS_MIX = 1107 * MiB, WS_MLP = 1235 * MiB;
constexpr size_t WS_END = 1235 * MiB;
static_assert(WS_WIN + (size_t)IN_PAD * D * 2 <= WS_WO && WS_A1 + (size_t)MT * D * 2 <= WS_Q && WS_KB + (size_t)MT * KEYW * 2 <= WS_V && WS_V + (size_t)MT * VALW * 2 <= WS_SR && WS_LR + (size_t)MT * 32 * 4 <= WS_OF && WS_HMID + (size_t)M * FF * 2 <= WS_MIX && WS_Y + (size_t)M * D * 2 <= WS_MIX, "d_ws map");
constexpr int CW_BAR = 4096, CW_VB = 12288;

constexpr int LDS_CTL_OFF = 155648, LDS_BYTES = 159744;

#define GAS __attribute__((address_space(1)))
#define LAS __attribute__((address_space(3)))
typedef unsigned short bf16;
typedef unsigned v4u __attribute__((ext_vector_type(4)));
typedef unsigned v2u __attribute__((ext_vector_type(2)));
typedef float f32x4 __attribute__((ext_vector_type(4)));
typedef float f32x2 __attribute__((ext_vector_type(2)));
typedef short bf16x8 __attribute__((ext_vector_type(8)));
typedef GAS unsigned gu32;
#define LDS_WAIT() asm volatile("s_waitcnt lgkmcnt(0)" ::: "memory")
#define LDS_BARRIER() asm volatile("s_waitcnt lgkmcnt(0)\n\ts_barrier" ::: "memory")
__device__ __forceinline__ unsigned f2bf(float f) { unsigned u = __builtin_bit_cast(unsigned, f); return (u + 0x7fffu + ((u >> 16) & 1u)) >> 16; }
typedef __bf16 bf16x2_hw __attribute__((ext_vector_type(2)));
__device__ __forceinline__ unsigned pk2(float lo, float hi) { const f32x2 v = {lo, hi}; return __builtin_bit_cast(unsigned, __builtin_convertvector(v, bf16x2_hw)); }
__device__ __forceinline__ float bf_lo(unsigned w) { return __builtin_bit_cast(float, w << 16); }
__device__ __forceinline__ float bf_hi(unsigned w) { return __builtin_bit_cast(float, w & 0xffff0000u); }
__device__ __forceinline__ float bf1(bf16 h) { return __builtin_bit_cast(float, (unsigned)h << 16); }
__device__ __forceinline__ float wave_sum(float v) {
#pragma unroll
    for (int o = 1; o < 64; o <<= 1) v += __shfl_xor(v, o);
    return v;
}
__device__ __forceinline__ void st_global_b64(void* p, v2u v) { asm volatile("global_store_dwordx2 %0, %1, off\n\ts_nop 1" :: "v"(p), "v"(v) : "memory"); }
__device__ __forceinline__ void st_global_b128(void* p, v4u v) { asm volatile("global_store_dwordx4 %0, %1, off\n\ts_nop 1" :: "v"(p), "v"(v) : "memory"); }
#define XB_TMO      128
#define XB_XCNT(j)  (256  + 64 * (j))
#define XB_XSUB(j)  (1280 + 64 * (j))
#define XB_XGEN(j)  (2304 + 64 * (j))
#define XB_TOP      3328
#define XB_TOPGEN   3392
#define XCD_BAR_WORDS 3456
#define XB_SPIN_CAP (1u << 18)

__device__ __forceinline__ unsigned xb_ld(unsigned* p)              { return __hip_atomic_load(p, __ATOMIC_RELAXED, __HIP_MEMORY_SCOPE_AGENT); }
__device__ __forceinline__ unsigned xb_add(unsigned* p, unsigned v) { return __hip_atomic_fetch_add(p, v, __ATOMIC_RELAXED, __HIP_MEMORY_SCOPE_AGENT); }
__device__ __forceinline__ unsigned xb_xcc_id() { return (unsigned)__builtin_amdgcn_s_getreg((3 << 11) | 20) & 0xFu; }
#define XB_SPIN(cond, bar) do { unsigned _sp = 0; while (cond) { __builtin_amdgcn_s_sleep(1); \
    if ((++_sp & 255u) == 0u) { if (xb_ld(&(bar)[XB_TMO])) break; if (_sp > XB_SPIN_CAP) { atomicAdd(&(bar)[XB_TMO], 1u); break; } } } } while (0)

struct XcdBarrier {
    unsigned* bar; unsigned x;
    volatile LAS unsigned* st;
};

__device__ __forceinline__ XcdBarrier xcd_barrier_post(unsigned* bar, volatile LAS unsigned* st) {
    XcdBarrier b; b.bar = bar; b.x = xb_xcc_id(); b.st = st;
    if (threadIdx.x == 0) (void)xb_add(&bar[XB_XCNT(b.x)], 1u);
    return b;
}
__device__ __forceinline__ void xcd_barrier_complete(unsigned* bar, unsigned x, unsigned& nloc, unsigned& nx) {
    const unsigned G = gridDim.x * gridDim.y * gridDim.z;
    unsigned sum, cnt, mine, sp = 0u;
    for (;;) {
        sum = 0u; cnt = 0u; mine = 0u;
#pragma unroll
        for (unsigned j = 0; j < 16; ++j) { const unsigned c = xb_ld(&bar[XB_XCNT(j)]); sum += c; cnt += (c > 0u) ? 1u : 0u; mine = (j == x) ? c : mine; }
        if (sum == G) break;
        __builtin_amdgcn_s_sleep(1);
        if ((++sp & 255u) == 0u) { if (xb_ld(&bar[XB_TMO])) break; if (sp > XB_SPIN_CAP) { atomicAdd(&bar[XB_TMO], 1u); break; } }
    }
    nloc = mine > 0u ? mine : 1u; nx = cnt > 0u ? cnt : 1u;
}

__device__ __forceinline__ void xcd_barrier(const XcdBarrier& b) {
    asm volatile("s_waitcnt vmcnt(0)" ::: "memory");
    __syncthreads();
    if (threadIdx.x == 0) {
        unsigned* bar = b.bar;
        __builtin_amdgcn_s_waitcnt(0);
        unsigned nloc = b.st[0], nx = b.st[1];
        if (nloc == 0u) { xcd_barrier_complete(bar, b.x, nloc, nx); b.st[0] = nloc; b.st[1] = nx; }
        const unsigned old = xb_add(&bar[XB_XSUB(b.x)], 1u);
        const unsigned gen = old / nloc;
        if (old + 1u == (gen + 1u) * nloc) {
            __builtin_amdgcn_fence(__ATOMIC_RELEASE, "agent");
            asm volatile("s_waitcnt vmcnt(0)" ::: "memory");
            const unsigned og = xb_add(&bar[XB_TOP], 1u);
            const unsigned tg = og / nx;
            if (og + 1u == (tg + 1u) * nx) xb_add(&bar[XB_TOPGEN], 1u);
            else XB_SPIN(xb_ld(&bar[XB_TOPGEN]) == tg, bar);
            __builtin_amdgcn_fence(__ATOMIC_ACQUIRE, "agent");
            xb_add(&bar[XB_XGEN(b.x)], 1u);
            asm volatile("s_waitcnt vmcnt(0)" ::: "memory");
        } else {
            XB_SPIN(xb_ld(&bar[XB_XGEN(b.x)]) == gen, bar);
            __builtin_amdgcn_fence(__ATOMIC_ACQUIRE, "agent");
            asm volatile("s_waitcnt vmcnt(0)" ::: "memory");
        }
    }
    __syncthreads();
}

struct Params { const float* in[23]; float* out; unsigned char* ws; };
struct Frame {
    LAS unsigned char* lds;
    int tid, lane, wave, G, bid;
};
__device__ __forceinline__ Frame mk_frame(LAS unsigned char* lds) { Frame F; int t = threadIdx.x; asm volatile("" : "+v"(t));
    F.lds = lds; F.tid = t; F.lane = t & 63; F.wave = __builtin_amdgcn_readfirstlane(t >> 6); F.G = gridDim.x; F.bid = blockIdx.x; return F; }
enum { I_X = 0, I_C, I_CTX, I_CCTX, I_WADA, I_BADA, I_PRE1, I_POST1, I_PRE2, I_POST2, I_WIN, I_WDF, I_BDF, I_WDB, I_BDB, I_GNG, I_SGLG, I_SGLB, I_WS, I_BS, I_WO, I_W1, I_W2 };

__device__ __forceinline__ void p0_transpose_item(const float* W, int K, int N, bf16* WT, int k0, int n0, int dst_row, LAS float* scr, int lane) {
    f32x4 v[16]; const int lr = lane >> 4, lc = (lane & 15) * 4;
#pragma unroll
    for (int i = 0; i < 16; ++i) v[i] = __builtin_nontemporal_load((const f32x4*)(W + (size_t)(k0 + 4 * i + lr) * N + n0 + lc));
#pragma unroll
    for (int i = 0; i < 16; ++i) { LAS float* d = scr + (4 * i + lr) * 65 + lc; d[0] = v[i][0]; d[1] = v[i][1]; d[2] = v[i][2]; d[3] = v[i][3]; }
    LDS_WAIT(); asm volatile("" ::: "memory");
    const int c = lane & 7;
#pragma unroll
    for (int j = 0; j < 8; ++j) { const int n = (lane >> 3) + 8 * j; const LAS float* s = scr + (8 * c) * 65 + n;
        v4u o; o.x = pk2(s[0 * 65], s[1 * 65]); o.y = pk2(s[2 * 65], s[3 * 65]); o.z = pk2(s[4 * 65], s[5 * 65]); o.w = pk2(s[6 * 65], s[7 * 65]);
        *(v4u*)(WT + (size_t)(dst_row + n) * K + k0 + 8 * c) = o; }
    LDS_WAIT(); asm volatile("" ::: "memory");
}
__device__ __forceinline__ float silu_f(float v) { return v / (1.0f + __expf(-v)); }

__device__ __forceinline__ void p0_adaln(LAS unsigned char* lds_, const Params& p) {
    const Frame F = mk_frame(lds_);
    unsigned char* ws = p.ws;
    {
        LAS float* sc = (LAS float*)F.lds;
        LAS float* red = (LAS float*)(F.lds + 81920);
        { f32x4 cv[10];
#pragma unroll
          for (int j = 0; j < 10; ++j) { const int i4 = F.tid + NTHR * j, r = i4 >> 10, k4 = i4 & 1023; cv[j] = *(const f32x4*)((r < 4 ? p.in[I_C] + r * D : p.in[I_CCTX]) + 4 * k4); }
#pragma unroll
          for (int j = 0; j < 10; ++j) { const int i4 = F.tid + NTHR * j; *(LAS f32x4*)(sc + 4 * i4) = (f32x4){silu_f(cv[j][0]), silu_f(cv[j][1]), silu_f(cv[j][2]), silu_f(cv[j][3])}; } }
        __syncthreads();
        const float* W = p.in[I_WADA]; const float* bA = p.in[I_BADA]; float* mod = (float*)(ws + WS_MOD);
        constexpr int NT = NMOD * D;
        for (int cb = F.bid; cb < NT / 96; cb += F.G) {
            const int r8 = F.lane >> 3, c = F.lane & 7;
            f32x4 a[5][3];
#pragma unroll
            for (int r = 0; r < 5; ++r)
#pragma unroll
                for (int q = 0; q < 3; ++q) a[r][q] = (f32x4){0.f, 0.f, 0.f, 0.f};
            const float* wp = W + (size_t)(F.wave * 512 + r8) * NT + cb * 96 + 4 * c;
            f32x4 wa[4][3], wb[4][3];
#define ADA_LD(Wv, it0) do { _Pragma("unroll") for (int u = 0; u < 4; ++u) { const float* wr = wp + (size_t)(8 * ((it0) + u)) * NT; Wv[u][0] = __builtin_nontemporal_load((const f32x4*)(wr)); Wv[u][1] = __builtin_nontemporal_load((const f32x4*)(wr + 32)); Wv[u][2] = __builtin_nontemporal_load((const f32x4*)(wr + 64)); } } while (0)
#define ADA_USE(Wv, it0) do { _Pragma("unroll") for (int u = 0; u < 4; ++u) { const int k = F.wave * 512 + 8 * ((it0) + u) + r8; \
                _Pragma("unroll") for (int r = 0; r < 5; ++r) { const float sv = sc[r * D + k]; a[r][0] += Wv[u][0] * sv; a[r][1] += Wv[u][1] * sv; a[r][2] += Wv[u][2] * sv; } } } while (0)
            ADA_LD(wa, 0);
#pragma unroll 1
            for (int it = 0; it < 64; it += 8) { ADA_LD(wb, it + 4); ADA_USE(wa, it); if (it + 8 < 64) ADA_LD(wa, it + 8); ADA_USE(wb, it + 4); }
#undef ADA_LD
#undef ADA_USE
#pragma unroll
            for (int r = 0; r < 5; ++r)
#pragma unroll
                for (int q = 0; q < 3; ++q)
#pragma unroll
                    for (int j = 0; j < 4; ++j) { float v = a[r][q][j]; v += __shfl_xor(v, 8); v += __shfl_xor(v, 16); v += __shfl_xor(v, 32); a[r][q][j] = v; }
            if (r8 == 0) {
#pragma unroll
                for (int r = 0; r < 5; ++r)
#pragma unroll
                    for (int q = 0; q < 3; ++q) *(LAS f32x4*)(red + (F.wave * 5 + r) * 96 + 32 * q + 4 * c) = a[r][q]; }
            __syncthreads();
            if (F.tid < 480) { const int r = F.tid / 96, n = F.tid % 96; float s = bA[cb * 96 + n];
#pragma unroll
                for (int w = 0; w < 8; ++w) s += red[(w * 5 + r) * 96 + n];
                mod[(size_t)r * NT + cb * 96 + n] = s; }
            __syncthreads();
        }
        __syncthreads();
    }
}
__device__ __forceinline__ void p0_prologue(LAS unsigned char* lds_, const Params& p) {
    const Frame F = mk_frame(lds_);
    unsigned char* ws = p.ws;
    if (F.bid == 0) {
        float* tab = (float*)(ws + WS_ROPE);
        for (int i = F.tid; i < 2048; i += NTHR) { const int pos = i >> 5, j = i & 31;
            const float inv = exp2f(-(float)j * (13.287712379549449f / 32.0f));
            const float ang = (float)pos * inv; float f = ang * 0.15915494309189535f; f -= floorf(f);
            tab[2 * i] = __builtin_amdgcn_cosf(f); tab[2 * i + 1] = __builtin_amdgcn_sinf(f); }
    }
    { v4u* z = (v4u*)(ws + WS_WIN + (size_t)IN_COLS * D * 2); const size_t n = (size_t)(IN_PAD - IN_COLS) * D * 2 / 16;
      for (size_t i = (size_t)F.bid * NTHR + F.tid; i < n; i += (size_t)F.G * NTHR) z[i] = (v4u){0u, 0u, 0u, 0u}; }
    {
        LAS float* scr = (LAS float*)(F.lds + F.wave * 16896);
        const int gw = F.bid * NWAVES + F.wave, NGW = F.G * NWAVES;
        constexpr int NB_IN = 96 + 64 + 1;
        constexpr int I_IN = (D / 64) * NB_IN, I_O = (D / 64) * (D / 64), I_1 = (D / 64) * (FF / 64), I_2 = (FF / 64) * (D / 64);
        constexpr int NITEMS = I_IN + I_O + I_1 + I_2;
        bf16* WinT = (bf16*)(ws + WS_WIN); bf16* WoT = (bf16*)(ws + WS_WO); bf16* W1T = (bf16*)(ws + WS_W1); bf16* W2T = (bf16*)(ws + WS_W2);
        for (int it = gw; it < NITEMS; it += NGW) {
            int r = it;
            if (r < I_IN) { const int kb = r / NB_IN, nb = r % NB_IN;
                if (nb < 96) p0_transpose_item(p.in[I_WIN], D, IN_COLS, WinT, 64 * kb, 64 * nb, 64 * nb, scr, F.lane);
                else if (nb < 160) p0_transpose_item(p.in[I_WIN], D, IN_COLS, WinT, 64 * kb, C_SG + 64 * (nb - 96), C_LF + 64 * (nb - 96), scr, F.lane);
                else {
                    const float* W = p.in[I_WIN]; const int k0 = 64 * kb;
#pragma unroll 8
                    for (int i = 0; i < 32; ++i) { const int kk = 2 * i + (F.lane >> 5); scr[kk * 65 + (F.lane & 31)] = W[(size_t)(k0 + kk) * IN_COLS + C_LF + (F.lane & 31)]; }
                    LDS_WAIT(); asm volatile("" ::: "memory");
                    const int c = F.lane & 7;
#pragma unroll
                    for (int j = 0; j < 4; ++j) { const int n = (F.lane >> 3) + 8 * j; const LAS float* s2 = scr + (8 * c) * 65 + n;
                        v4u o; o.x = pk2(s2[0 * 65], s2[1 * 65]); o.y = pk2(s2[2 * 65], s2[3 * 65]); o.z = pk2(s2[4 * 65], s2[5 * 65]); o.w = pk2(s2[6 * 65], s2[7 * 65]);
                        *(v4u*)(WinT + (size_t)(IN_COLS - 32 + n) * D + k0 + 8 * c) = o; }
                    LDS_WAIT(); asm volatile("" ::: "memory");
                }
                continue; } r -= I_IN;
            if (r < I_O) { const int nbk = D / 64, kb = r / nbk, nb = r % nbk; p0_transpose_item(p.in[I_WO], D, D, WoT, 64 * kb, 64 * nb, 64 * nb, scr, F.lane); continue; } r -= I_O;
            if (r < I_1) { const int nbk = FF / 64, kb = r / nbk, nb = r % nbk; p0_transpose_item(p.in[I_W1], D, FF, W1T, 64 * kb, 64 * nb, 64 * nb, scr, F.lane); continue; } r -= I_1;
            { const int nbk = D / 64, kb = r / nbk, nb = r % nbk; p0_transpose_item(p.in[I_W2], FF, D, W2T, 64 * kb, 64 * nb, 64 * nb, scr, F.lane); }
        }
    }
}

__device__ __forceinline__ void p1_rows(LAS unsigned char* lds_, const Params& p) {
    const Frame F = mk_frame(lds_);
    LAS float* cA = (LAS float*)F.lds; LAS float* cB = cA + D;
    const float* mod = (const float*)(p.ws + WS_MOD); bf16* A1 = (bf16*)(p.ws + WS_A1);
    const int per = (MT + F.G - 1) / F.G; int r0 = F.bid * per; const int rend = (r0 + per < MT) ? r0 + per : MT;
    while (r0 < rend) {
        const int bb = r0 < M ? r0 / SEQ : 4; const int bend = r0 < M ? (bb + 1) * SEQ : MT; const int r1 = rend < bend ? rend : bend;
        __syncthreads();
        { float g_[8], sc_[8], sh_[8];
#pragma unroll
          for (int j = 0; j < 8; ++j) { const int c = F.tid + NTHR * j; g_[j] = p.in[I_PRE1][c]; sc_[j] = mod[(size_t)bb * NMOD * D + D + c]; sh_[j] = mod[(size_t)bb * NMOD * D + c]; }
#pragma unroll
          for (int j = 0; j < 8; ++j) { const int c = F.tid + NTHR * j; cA[c] = g_[j] * (1.0f + sc_[j]); cB[c] = sh_[j]; } }
        __syncthreads();
        f32x4 v[16], vn[16];
#define P1_LD(Vv, r_) do { const float* xr_ = (r_) < M ? p.in[I_X] + (size_t)(r_) * D : p.in[I_CTX] + (size_t)((r_) - M) * D; \
            _Pragma("unroll") for (int j = 0; j < 16; ++j) Vv[j] = __builtin_nontemporal_load((const f32x4*)(xr_ + 256 * j + 4 * F.lane)); } while (0)
        if (r0 + F.wave < r1) P1_LD(vn, r0 + F.wave);
        for (int r = r0 + F.wave; r < r1; r += NWAVES) {
#pragma unroll
            for (int j = 0; j < 16; ++j) v[j] = vn[j];
            if (r + NWAVES < r1) P1_LD(vn, r + NWAVES);
            float ss = 0.f;
#pragma unroll
            for (int j = 0; j < 16; ++j) ss += (v[j][0] * v[j][0] + v[j][1] * v[j][1]) + (v[j][2] * v[j][2] + v[j][3] * v[j][3]);
            const float rstd = rsqrtf(wave_sum(ss) * (1.0f / D) + EPS);
            bf16* orow = A1 + (size_t)r * D;
#pragma unroll
            for (int j = 0; j < 16; ++j) { const f32x4 a = *(LAS f32x4*)(cA + 256 * j + 4 * F.lane), b = *(LAS f32x4*)(cB + 256 * j + 4 * F.lane); const f32x4 o = v[j] * rstd * a + b;
                v2u w; w.x = pk2(o[0], o[1]); w.y = pk2(o[2], o[3]); st_global_b64(orow + 256 * j + 4 * F.lane, w); }
        }
#undef P1_LD
        r0 = r1;
    }
    __syncthreads();
}

__device__ __forceinline__ bf16x8 ldfrag(const LAS unsigned char* base, int row, int stride, int kbyte) { return *(const LAS bf16x8*)(base + row * stride + kbyte); }
__device__ __forceinline__ void p3_sg(LAS unsigned char* lds_, const Params& p) {
    const Frame F = mk_frame(lds_);
    constexpr int WS_OFF = 0, VN_OFF = 34816, ST_OFF = 69632, STR = 272;
    const bf16* VV = (const bf16*)(p.ws + WS_VV); const bf16* U = (const bf16*)(p.ws + WS_U); bf16* Y = (bf16*)(p.ws + WS_Y); const float* sgstat = (const float*)(p.ws + WS_SGSTAT);
    const int l15 = F.lane & 15, lq = F.lane >> 4;
    constexpr int NUNITS = SGG * BATCH * (SEQ / SGC) * 4;
    int u0, u1; { const int nt = (F.G > pg8::N_TAIL) ? pg8::N_TAIL : 0, nf = F.G - nt; int lo = (NUNITS - 10 * nf) / F.G; if (lo < 0 || nt == 0) lo = 0; int hi = nf > 0 ? (NUNITS - lo * nt + nf - 1) / nf : 0;
        if (nt == 0) { hi = (NUNITS + F.G - 1) / F.G; }
        if (F.bid >= nt) { u0 = (F.bid - nt) * hi; u1 = u0 + hi; } else { u0 = nf * hi + F.bid * lo; u1 = u0 + lo; }
        if (u0 > NUNITS) u0 = NUNITS; if (u1 > NUNITS) u1 = NUNITS;
        if (nt > 0 && F.bid == nt - 1) u1 = NUNITS; }
    int gcur = -1;
    bf16x8 Iev, Iod; { const int ie = l15 - 8 * lq, io = 16 + l15 - 8 * lq; unsigned iev[4] = {0u, 0u, 0u, 0u}, iod[4] = {0u, 0u, 0u, 0u};
#pragma unroll
        for (int e = 0; e < 8; ++e) { if (ie == e) iev[e >> 1] = (e & 1) ? 0x3F800000u : 0x00003F80u; if (io == e) iod[e >> 1] = (e & 1) ? 0x3F800000u : 0x00003F80u; }
        Iev = __builtin_bit_cast(bf16x8, (v4u){iev[0], iev[1], iev[2], iev[3]}); Iod = __builtin_bit_cast(bf16x8, (v4u){iod[0], iod[1], iod[2], iod[3]}); }
    struct SgRegs { v4u av[4]; f32x4 st[4]; v2u uu[8]; float lg[8], lb[8]; };
#define SG_DECODE(un_) const int g_ = (un_) / 512, rem_ = (un_) % 512, b_ = rem_ / 128, n_ = (rem_ % 128) / 4, cs_ = rem_ % 4; const int row0_ = b_ * SEQ + n_ * SGC, ch0_ = g_ * SGGW + cs_ * 128;
#define SG_LOAD(R, un_) do { SG_DECODE(un_) \
        _Pragma("unroll") for (int ks = 0; ks < 4; ++ks) R.av[ks] = *(const v4u*)(VV + (size_t)(row0_ + 16 * F.wave + l15) * SGW + ch0_ + 32 * ks + 8 * lq); \
        _Pragma("unroll") for (int k = 0; k < 4; ++k) R.st[k] = *(const f32x4*)(sgstat + (size_t)(row0_ + (F.tid >> 2)) * 64 + (F.tid & 3) * 16 + 4 * k); \
        _Pragma("unroll") for (int ti = 0; ti < 8; ++ti) R.uu[ti] = *(const v2u*)(U + (size_t)(row0_ + 16 * ti + l15) * SGW + ch0_ + 16 * F.wave + 4 * lq); \
        _Pragma("unroll") for (int ks = 0; ks < 4; ++ks) { R.lg[2 * ks] = p.in[I_SGLG][ch0_ + 32 * ks + l15]; R.lb[2 * ks] = p.in[I_SGLB][ch0_ + 32 * ks + l15]; R.lg[2 * ks + 1] = p.in[I_SGLG][ch0_ + 32 * ks + 16 + l15]; R.lb[2 * ks + 1] = p.in[I_SGLB][ch0_ + 32 * ks + 16 + l15]; } } while (0)
    SgRegs R, Rn; float bsv[8] = {0.f, 0.f, 0.f, 0.f, 0.f, 0.f, 0.f, 0.f};
    if (u0 < u1) SG_LOAD(Rn, u0);
    for (int un = u0; un < u1; ++un) {
        SG_DECODE(un) const int g = g_, row0 = row0_, ch0 = ch0_;
        R = Rn;
        if (un + 1 < u1) SG_LOAD(Rn, un + 1);
        LDS_BARRIER();
        if (g != gcur) { gcur = g; const float* W = p.in[I_WS] + (size_t)g * SGC * SGC;
#pragma unroll
            for (int ti = 0; ti < 8; ++ti) bsv[ti] = p.in[I_BS][g * SGC + 16 * ti + l15];
            for (int i = F.tid; i < SGC * SGC / 4; i += NTHR) { const int r = i / 32, c4 = (i % 32) * 4; const f32x4 w = *(const f32x4*)(W + r * SGC + c4);
                v2u o; o.x = pk2(w[0], w[1]); o.y = pk2(w[2], w[3]); *(LAS v2u*)(F.lds + WS_OFF + r * STR + c4 * 2) = o; } }
        { const int row = F.tid >> 2, part = F.tid & 3; float s1 = 0.f, s2 = 0.f;
#pragma unroll
          for (int k = 0; k < 4; ++k) { s1 += R.st[k][0] + R.st[k][2]; s2 += R.st[k][1] + R.st[k][3]; }
          s1 += __shfl_xor(s1, 1); s2 += __shfl_xor(s2, 1); s1 += __shfl_xor(s1, 2); s2 += __shfl_xor(s2, 2);
          if (part == 0) { const float mu = s1 * (1.0f / SGW), var = s2 * (1.0f / SGW) - mu * mu; *(LAS f32x2*)(F.lds + ST_OFF + row * 8) = (f32x2){mu, rsqrtf(var + EPS)}; } }
        LDS_BARRIER();
        { const int tm = F.wave; const f32x4 stA = *(const LAS f32x4*)(F.lds + ST_OFF + (16 * tm + 4 * lq) * 8), stB = *(const LAS f32x4*)(F.lds + ST_OFF + (16 * tm + 4 * lq + 2) * 8);
          const float mu[4] = {stA[0], stA[2], stB[0], stB[2]}, rs[4] = {stA[1], stA[3], stB[1], stB[3]};
#pragma unroll
          for (int ks = 0; ks < 4; ++ks) { const f32x4 z = (f32x4){0.f, 0.f, 0.f, 0.f}; const bf16x8 a = __builtin_bit_cast(bf16x8, R.av[ks]);
              const f32x4 d0 = __builtin_amdgcn_mfma_f32_16x16x32_bf16(a, Iev, z, 0, 0, 0), d1 = __builtin_amdgcn_mfma_f32_16x16x32_bf16(a, Iod, z, 0, 0, 0);
              const int ca = 32 * ks + l15, cb = ca + 16; const float ga = R.lg[2 * ks], ba = R.lb[2 * ks], gb = R.lg[2 * ks + 1], bb = R.lb[2 * ks + 1];
              float ya[4], yb[4];
#pragma unroll
              for (int r = 0; r < 4; ++r) { ya[r] = (d0[r] - mu[r]) * rs[r] * ga + ba; yb[r] = (d1[r] - mu[r]) * rs[r] * gb + bb; }
              *(LAS v2u*)(F.lds + VN_OFF + ca * STR + (16 * tm + 4 * lq) * 2) = (v2u){pk2(ya[0], ya[1]), pk2(ya[2], ya[3])};
              *(LAS v2u*)(F.lds + VN_OFF + cb * STR + (16 * tm + 4 * lq) * 2) = (v2u){pk2(yb[0], yb[1]), pk2(yb[2], yb[3])}; } }
        LDS_BARRIER();
        f32x4 acc[8];
#pragma unroll
        for (int ti = 0; ti < 8; ++ti) acc[ti] = (f32x4){0.f, 0.f, 0.f, 0.f};
#pragma unroll
        for (int ks = 0; ks < 4; ++ks) { const bf16x8 a = ldfrag(F.lds + VN_OFF, 16 * F.wave + l15, STR, (8 * lq + 32 * ks) * 2);
#pragma unroll
            for (int ti = 0; ti < 8; ++ti) { const bf16x8 bb = ldfrag(F.lds + WS_OFF, 16 * ti + l15, STR, (8 * lq + 32 * ks) * 2); acc[ti] = __builtin_amdgcn_mfma_f32_16x16x32_bf16(a, bb, acc[ti], 0, 0, 0); } }
#pragma unroll
        for (int ti = 0; ti < 8; ++ti) { const int i = 16 * ti + l15, c = 16 * F.wave + 4 * lq; const float bs = bsv[ti];
            const v2u uu = R.uu[ti];
            const float o0 = bf_lo(uu.x) * (acc[ti][0] + bs), o1 = bf_hi(uu.x) * (acc[ti][1] + bs), o2 = bf_lo(uu.y) * (acc[ti][2] + bs), o3 = bf_hi(uu.y) * (acc[ti][3] + bs);
            v2u w; w.x = pk2(o0, o1); w.y = pk2(o2, o3); st_global_b64(Y + (size_t)(row0 + i) * D + VALW + ch0 + c, w); }
    }
#undef SG_LOAD
#undef SG_DECODE
    __syncthreads();
}


constexpr int BL_QT = 0, BL_KH = 17408, BL_ATT = 35840, BL_EBL = 45056, BLOB = 46080, VTIMG = 36864, NCH = 68;
constexpr size_t WS_BLOB = WS_MIX;
constexpr size_t WS_VT = WS_BLOB + (size_t)BATCH * HEADS * 2 * NCH * BLOB;
constexpr size_t WS_END2 = WS_VT + (size_t)BATCH * HEADS * NCH * VTIMG;
__device__ __forceinline__ float dpp_swap1(float x) { return __builtin_bit_cast(float, __builtin_amdgcn_update_dpp(0, __builtin_bit_cast(int, x), 0xB1, 0xF, 0xF, true)); }
__device__ __forceinline__ float logsig16(float a) { return (fminf(a, 0.f) - __logf(1.0f + __expf(-fabsf(a)))) * (1.0f / 16.0f); }
__device__ __forceinline__ void p3_gla_pre(LAS unsigned char* lds_, const Params& p) {
    const Frame F = mk_frame(lds_);
    constexpr int KT = 46080, GT = 63488, VTI = 65536;
    constexpr int S128 = 272, S64 = 144;
    const bf16* Qg = (const bf16*)(p.ws + WS_Q); const bf16* Kg = (const bf16*)(p.ws + WS_KB); const bf16* Vg = (const bf16*)(p.ws + WS_V); const float* LRg = (const float*)(p.ws + WS_LR);
    const float* tab = (const float*)(p.ws + WS_ROPE);
    const int w = F.wave, lane = F.lane, l15 = lane & 15, lq = lane >> 4, tt = w & 3, chh = w >> 2;
    float csC[2][4], snC[2][4];
#pragma unroll
    for (int pp = 0; pp < 2; ++pp)
#pragma unroll
        for (int r = 0; r < 4; ++r) { const f32x2 t = *(const f32x2*)(tab + ((16 * tt + 4 * lq + r) * 32 + 16 * pp + l15) * 2); csC[pp][r] = t.x; snC[pp][r] = t.y; }
    bf16x8 Iev, Iod; { const int ie = l15 - 8 * lq, io = 16 + l15 - 8 * lq; unsigned iev[4] = {0u, 0u, 0u, 0u}, iod[4] = {0u, 0u, 0u, 0u};
#pragma unroll
        for (int e = 0; e < 8; ++e) { if (ie == e) iev[e >> 1] = (e & 1) ? 0x3F800000u : 0x00003F80u; if (io == e) iod[e >> 1] = (e & 1) ? 0x3F800000u : 0x00003F80u; }
        Iev = __builtin_bit_cast(bf16x8, (v4u){iev[0], iev[1], iev[2], iev[3]}); Iod = __builtin_bit_cast(bf16x8, (v4u){iod[0], iod[1], iod[2], iod[3]}); }
    constexpr int NLAT = BATCH * HEADS * 64, NCTX = BATCH * HEADS * 4;
    const int per = (NLAT + F.G - 1) / F.G;
    const int n_lat = (F.bid * per >= NLAT) ? 0 : ((NLAT - F.bid * per) < per ? (NLAT - F.bid * per) : per);
    const int n_ctx = F.bid < NCTX ? (NCTX - F.bid + F.G - 1) / F.G : 0, total = n_lat + n_ctx;
    struct PreRegs { v4u q[2], k[2]; f32x4 lr[4]; f32x2 rt[2]; };
#define PRE_DECODE(i_) int b_, h_, cidx_; if ((i_) < n_lat) { const int un_ = F.bid * per + (i_); b_ = un_ >> 9; h_ = (un_ >> 6) & 7; cidx_ = 4 + (un_ & 63); } else { const int un_ = F.bid + ((i_) - n_lat) * F.G; b_ = un_ >> 5; h_ = (un_ >> 2) & 7; cidx_ = un_ & 3; } \
        const bool ctx_ = cidx_ < 4; const size_t row0_ = ctx_ ? (size_t)(M + b_ * CTXL + cidx_ * 64) : (size_t)(b_ * SEQ + (cidx_ - 4) * 64);
#define PRE_LOAD(R, i_) do { PRE_DECODE(i_) const size_t rt_ = row0_ + 16 * tt + l15; \
        _Pragma("unroll") for (int ksl = 0; ksl < 2; ++ksl) { if (!ctx_) R.q[ksl] = *(const v4u*)(Qg + rt_ * KEYW + h_ * DK + 64 * chh + 32 * ksl + 8 * lq); R.k[ksl] = *(const v4u*)(Kg + rt_ * KEYW + h_ * DK + 64 * chh + 32 * ksl + 8 * lq); } \
        _Pragma("unroll") for (int pp_ = 0; pp_ < 2; ++pp_) R.rt[pp_] = *(const f32x2*)(tab + ((ctx_ ? 0 : cidx_ - 4) * 32 + 16 * pp_ + l15) * 2); \
        _Pragma("unroll") for (int d = 0; d < 2; ++d) { R.lr[2 * d] = *(const f32x4*)(LRg + rt_ * 32 + d * 16 + 8 * (lq & 1)); R.lr[2 * d + 1] = *(const f32x4*)(LRg + rt_ * 32 + d * 16 + 8 * (lq & 1) + 4); } } while (0)
    PreRegs R, Rn;
    if (total > 0) PRE_LOAD(Rn, 0);
    bf16x8 wdf[2][4]; float bias[2][4]; int hcur = -1;
#pragma unroll
    for (int d = 0; d < 2; ++d)
#pragma unroll
        for (int tq = 0; tq < 4; ++tq) { wdf[d][tq] = Iev; bias[d][tq] = 0.f; }
    for (int it = 0; it < total; ++it) {
        PRE_DECODE(it) const int b = b_, h = h_, cidx = cidx_; const bool ctx = ctx_; const int ch = ctx ? cidx : cidx - 4;
        R = Rn;
        if (it + 1 < total) PRE_LOAD(Rn, it + 1);
        if (h != hcur) { hcur = h;
#pragma unroll
            for (int d = 0; d < 2; ++d) { const float* wd = p.in[d ? I_WDB : I_WDF]; const float* bd = p.in[d ? I_BDB : I_BDF];
#pragma unroll
                for (int tq = 0; tq < 4; ++tq) { const int c = h * DK + 64 * chh + 16 * tq + l15; unsigned pk[4];
#pragma unroll
                    for (int e = 0; e < 8; e += 2) pk[e >> 1] = pk2(wd[(8 * (lq & 1) + e) * KEYW + c], wd[(8 * (lq & 1) + e + 1) * KEYW + c]);
                    wdf[d][tq] = __builtin_bit_cast(bf16x8, (v4u){pk[0], pk[1], pk[2], pk[3]}); bias[d][tq] = bd[c]; } } }
        LDS_BARRIER();
        const f32x4 z4 = (f32x4){0.f, 0.f, 0.f, 0.f};
        float qv[4][4], kv[4][4];
#pragma unroll
        for (int ksl = 0; ksl < 2; ++ksl) { const bf16x8 ak = __builtin_bit_cast(bf16x8, R.k[ksl]);
            const f32x4 k0 = __builtin_amdgcn_mfma_f32_16x16x32_bf16(ak, Iev, z4, 0, 0, 0), k1 = __builtin_amdgcn_mfma_f32_16x16x32_bf16(ak, Iod, z4, 0, 0, 0);
            f32x4 q0 = z4, q1 = z4; if (!ctx) { const bf16x8 aq = __builtin_bit_cast(bf16x8, R.q[ksl]); q0 = __builtin_amdgcn_mfma_f32_16x16x32_bf16(aq, Iev, z4, 0, 0, 0); q1 = __builtin_amdgcn_mfma_f32_16x16x32_bf16(aq, Iod, z4, 0, 0, 0); }
#pragma unroll
            for (int r = 0; r < 4; ++r) { kv[2 * ksl][r] = k0[r]; kv[2 * ksl + 1][r] = k1[r]; qv[2 * ksl][r] = q0[r]; qv[2 * ksl + 1][r] = q1[r]; } }
        if (!ctx) {
#pragma unroll
            for (int pp = 0; pp < 2; ++pp) { const float c0 = R.rt[pp].x, s0 = R.rt[pp].y;
#pragma unroll
                for (int r = 0; r < 4; ++r) { const float cc = chh ? csC[pp][r] : c0, ss = chh ? snC[pp][r] : s0;
                    const float qa = qv[pp][r] * cc - qv[pp + 2][r] * ss, qb = qv[pp][r] * ss + qv[pp + 2][r] * cc; qv[pp][r] = qa; qv[pp + 2][r] = qb;
                    const float ka = kv[pp][r] * cc - kv[pp + 2][r] * ss, kb = kv[pp][r] * ss + kv[pp + 2][r] * cc; kv[pp][r] = ka; kv[pp + 2][r] = kb; } }
        }
#pragma unroll
        for (int dir = 0; dir < 2; ++dir) {
            bf16x8 afr; { const f32x4 l0 = R.lr[2 * dir], l1 = R.lr[2 * dir + 1];
                float x[8] = {l0[0], l0[1], l0[2], l0[3], l1[0], l1[1], l1[2], l1[3]}; unsigned pk[4];
#pragma unroll
                for (int e = 0; e < 8; e += 2) { float a0 = x[e], a1 = x[e + 1]; if (lq >= 2) { a0 -= bf_lo(pk2(a0, 0.f)); a1 -= bf_lo(pk2(a1, 0.f)); } pk[e >> 1] = pk2(a0, a1); }
                afr = __builtin_bit_cast(bf16x8, (v4u){pk[0], pk[1], pk[2], pk[3]}); }
            float cu[4][4];
#pragma unroll
            for (int tq = 0; tq < 4; ++tq) { const float bs = bias[dir][tq]; f32x4 a4 = (f32x4){bs, bs, bs, bs};
                a4 = __builtin_amdgcn_mfma_f32_16x16x32_bf16(afr, wdf[dir][tq], a4, 0, 0, 0);
#pragma unroll
                for (int r = 0; r < 4; ++r) cu[tq][r] = logsig16(a4[r]); }
#pragma unroll
            for (int tq = 0; tq < 4; ++tq) {
                if (!dir) { cu[tq][1] += cu[tq][0]; cu[tq][2] += cu[tq][1]; cu[tq][3] += cu[tq][2]; } else { cu[tq][2] += cu[tq][3]; cu[tq][1] += cu[tq][2]; cu[tq][0] += cu[tq][1]; }
                const float tl = dir ? cu[tq][0] : cu[tq][3]; float inc = tl;
                if (!dir) { float t = __shfl_up(inc, 16); if (lq >= 1) inc += t; t = __shfl_up(inc, 32); if (lq >= 2) inc += t; }
                else      { float t = __shfl_down(inc, 16); if (lq <= 2) inc += t; t = __shfl_down(inc, 32); if (lq <= 1) inc += t; }
                const float ex = inc - tl;
#pragma unroll
                for (int r = 0; r < 4; ++r) cu[tq][r] += ex;
                if (lq == (dir ? 0 : 3)) ((LAS float*)(F.lds + GT))[tt * DK + 64 * chh + 16 * tq + l15] = inc;
            }
            LDS_BARRIER();
#pragma unroll
            for (int tq = 0; tq < 4; ++tq) { const int c = 64 * chh + 16 * tq + l15; float off = 0.f, tot = 0.f;
#pragma unroll
                for (int t2 = 0; t2 < 4; ++t2) { const float g = ((const LAS float*)(F.lds + GT))[t2 * DK + c]; tot += g; if (dir ? (t2 > tt) : (t2 < tt)) off += g; }
                const float et = __expf(tot); if (tt == 0 && lq == 0) ((LAS float*)(F.lds + BL_EBL))[c] = et;
                float kh[4], qs[4], ks4[4];
#pragma unroll
                for (int r = 0; r < 4; ++r) { const float bq = cu[tq][r] + off, eb = __expf(bq), ei = __builtin_amdgcn_rcpf(eb);
                    const float kt = kv[tq][r] * ei; kh[r] = kt * et; ks4[r] = kt; qs[r] = qv[tq][r] * eb; }
                if (!ctx) {
                    const bool odd = l15 & 1; const int i0 = 16 * tt + 4 * lq + (odd ? 2 : 0), cd = (c & ~1) * 2;
                    const float q0 = dpp_swap1(odd ? qs[0] : qs[2]), q1 = dpp_swap1(odd ? qs[1] : qs[3]), k0 = dpp_swap1(odd ? ks4[0] : ks4[2]), k1 = dpp_swap1(odd ? ks4[1] : ks4[3]);
                    *(LAS unsigned*)(F.lds + BL_QT + i0 * S128 + cd) = odd ? pk2(q0, qs[2]) : pk2(qs[0], q0); *(LAS unsigned*)(F.lds + BL_QT + (i0 + 1) * S128 + cd) = odd ? pk2(q1, qs[3]) : pk2(qs[1], q1);
                    *(LAS unsigned*)(F.lds + KT + i0 * S128 + cd) = odd ? pk2(k0, ks4[2]) : pk2(ks4[0], k0); *(LAS unsigned*)(F.lds + KT + (i0 + 1) * S128 + cd) = odd ? pk2(k1, ks4[3]) : pk2(ks4[1], k1); }
                *(LAS v2u*)(F.lds + BL_KH + c * S64 + (16 * tt + 4 * lq) * 2) = (v2u){pk2(kh[0], kh[1]), pk2(kh[2], kh[3])}; }
            LDS_BARRIER();
            if (!ctx) {
                const int ti = w & 3;
#pragma unroll
                for (int t2 = 0; t2 < 2; ++t2) { const int tj = 2 * (w >> 2) + t2; f32x4 a4 = (f32x4){0.f, 0.f, 0.f, 0.f};
#pragma unroll
                    for (int ks = 0; ks < 4; ++ks) a4 = __builtin_amdgcn_mfma_f32_16x16x32_bf16(ldfrag(F.lds + KT, 16 * tj + l15, S128, (8 * lq + 32 * ks) * 2), ldfrag(F.lds + BL_QT, 16 * ti + l15, S128, (8 * lq + 32 * ks) * 2), a4, 0, 0, 0);
                    const int i = 16 * ti + l15, j0 = 16 * tj + 4 * lq; float m[4];
#pragma unroll
                    for (int r = 0; r < 4; ++r) { const int j = j0 + r; const bool keep = dir ? (j >= i) : (j <= i); m[r] = keep ? a4[r] : 0.f; }
                    *(LAS v2u*)(F.lds + BL_ATT + i * S64 + j0 * 2) = (v2u){pk2(m[0], m[1]), pk2(m[2], m[3])}; }
                LDS_BARRIER();
            }
            { unsigned char* bg = p.ws + WS_BLOB + ((size_t)((b * HEADS + h) * 2 + dir) * NCH + cidx) * BLOB;
              for (int i = F.tid; i < BLOB / 16; i += NTHR) st_global_b128(bg + i * 16, *(const LAS v4u*)(F.lds + i * 16));
            }
        }
    }
#undef PRE_LOAD
#undef PRE_DECODE
    __syncthreads();
}

__device__ __forceinline__ void p3_gla_scan(LAS unsigned char* lds_, const Params& p) {
    const Frame F = mk_frame(lds_);
    constexpr int BUFB = BLOB + 9216, ST0 = 2 * BUFB, STB = 17408, S128 = 272, S64 = 144;
    constexpr int NPIECE = BUFB / 1024;
    const int w = F.wave, lane = F.lane, l15 = lane & 15, lq = lane >> 4;
    const bf16* Vg = (const bf16*)(p.ws + WS_V);
    bf16x8 Iev, Iod; { const int ie = l15 - 8 * lq, io = 16 + l15 - 8 * lq; unsigned iev[4] = {0u, 0u, 0u, 0u}, iod[4] = {0u, 0u, 0u, 0u};
#pragma unroll
        for (int e = 0; e < 8; ++e) { if (ie == e) iev[e >> 1] = (e & 1) ? 0x3F800000u : 0x00003F80u; if (io == e) iod[e >> 1] = (e & 1) ? 0x3F800000u : 0x00003F80u; }
        Iev = __builtin_bit_cast(bf16x8, (v4u){iev[0], iev[1], iev[2], iev[3]}); Iod = __builtin_bit_cast(bf16x8, (v4u){iod[0], iod[1], iod[2], iod[3]}); }
    for (int un = F.bid; un < 256; un += F.G) {
        const int xcd = un & 7, slot = un >> 3, chain = xcd * 8 + (slot >> 2), dvs = slot & 3;
        const int b = chain >> 4, h = (chain >> 1) & 7, dir = chain & 1;
        bf16* Og = (bf16*)(p.ws + (dir ? WS_OB : WS_OF));
        const unsigned char* blobs = p.ws + WS_BLOB + (size_t)((b * HEADS + h) * 2 + dir) * NCH * BLOB;
        __syncthreads();
        for (int i = F.tid; i < STB / 4; i += NTHR) ((LAS unsigned*)(F.lds + ST0))[i] = 0u;
        f32x4 S[4];
#pragma unroll
        for (int tv = 0; tv < 4; ++tv) S[tv] = (f32x4){0.f, 0.f, 0.f, 0.f};
#define SCAN_CIDX(s) ((s) < 4 ? (dir ? 3 - (s) : (s)) : (dir ? 71 - (s) : (s)))
#define SCAN_ROW0(ci_) ((ci_) < 4 ? (size_t)(M + b * CTXL + (ci_) * 64) : (size_t)(b * SEQ + ((ci_) - 4) * 64))
#define SCAN_LD(R, s) do { const int ci_ = SCAN_CIDX(s); const unsigned char* bg_ = blobs + (size_t)ci_ * BLOB; \
            _Pragma("unroll") for (int j_ = 0; j_ < 6; ++j_) { const int q_ = F.tid + NTHR * j_; if (j_ < 5 || F.tid < 320) R[j_] = *(const v4u*)(bg_ + q_ * 16); } \
            R[6] = *(const v4u*)(Vg + (SCAN_ROW0(ci_) + 16 * (w & 3) + l15) * VALW + h * DV + dvs * 64 + 32 * (w >> 2) + 8 * lq); } while (0)
#define SCAN_ST(R, s) do { const int bo_ = ((s) & 1) * BUFB; \
            _Pragma("unroll") for (int j_ = 0; j_ < 6; ++j_) { const int q_ = F.tid + NTHR * j_; if (j_ < 5 || F.tid < 320) *(LAS v4u*)(F.lds + bo_ + q_ * 16) = R[j_]; } \
            { const bf16x8 a_ = __builtin_bit_cast(bf16x8, R[6]); const f32x4 z_ = (f32x4){0.f, 0.f, 0.f, 0.f}; \
              const f32x4 d0_ = __builtin_amdgcn_mfma_f32_16x16x32_bf16(a_, Iev, z_, 0, 0, 0), d1_ = __builtin_amdgcn_mfma_f32_16x16x32_bf16(a_, Iod, z_, 0, 0, 0); \
              LAS unsigned char* vt_ = F.lds + bo_ + BLOB + (32 * (w >> 2) + l15) * S64 + (16 * (w & 3) + 4 * lq) * 2; \
              *(LAS v2u*)vt_ = (v2u){pk2(d0_[0], d0_[1]), pk2(d0_[2], d0_[3])}; *(LAS v2u*)(vt_ + 16 * S64) = (v2u){pk2(d1_[0], d1_[1]), pk2(d1_[2], d1_[3])}; } } while (0)
        v4u RA[7], RB[7];
        SCAN_LD(RA, 0); SCAN_LD(RB, 1);
        SCAN_ST(RA, 0); SCAN_LD(RA, 2);
#pragma unroll 1
        for (int s2 = 0; s2 < NCH; s2 += 2) {
#pragma unroll
          for (int par = 0; par < 2; ++par) { const int s = s2 + par;
            const bool ctx = s < 4; const int ci = SCAN_CIDX(s); const int ch = ci - 4;
            const LAS unsigned char* buf = F.lds + (s & 1) * BUFB; const LAS unsigned char* vt = buf + BLOB;
            const LAS unsigned char* stc = F.lds + ST0 + (s & 1) * STB; LAS unsigned char* stn = F.lds + ST0 + ((s + 1) & 1) * STB;
            LDS_BARRIER();
            if (s + 1 < NCH) { if (par == 0) SCAN_ST(RB, s + 1); else SCAN_ST(RA, s + 1); }
            if (s + 3 < NCH) { if (par == 0) SCAN_LD(RB, s + 3); else SCAN_LD(RA, s + 3); }
            if (!ctx) {
                const int ti = w & 3; const size_t row0 = (size_t)(b * SEQ + ch * 64);
#pragma unroll
                for (int t2 = 0; t2 < 2; ++t2) { const int tv = 2 * (w >> 2) + t2; f32x4 o4 = (f32x4){0.f, 0.f, 0.f, 0.f};
#pragma unroll
                    for (int ks = 0; ks < 4; ++ks) o4 = __builtin_amdgcn_mfma_f32_16x16x32_bf16(ldfrag(stc, 16 * tv + l15, S128, (8 * lq + 32 * ks) * 2), ldfrag(buf + BL_QT, 16 * ti + l15, S128, (8 * lq + 32 * ks) * 2), o4, 0, 0, 0);
#pragma unroll
                    for (int ks = 0; ks < 2; ++ks) o4 = __builtin_amdgcn_mfma_f32_16x16x32_bf16(ldfrag(vt, 16 * tv + l15, S64, (8 * lq + 32 * ks) * 2), ldfrag(buf + BL_ATT, 16 * ti + l15, S64, (8 * lq + 32 * ks) * 2), o4, 0, 0, 0);
                    const int i = 16 * ti + l15, v0 = 16 * tv + 4 * lq;
                    st_global_b64(Og + (row0 + i) * VALW + h * DV + dvs * 64 + v0, (v2u){pk2(o4[0], o4[1]), pk2(o4[2], o4[3])}); }
            }
            { const f32x4 eb = *(const LAS f32x4*)(buf + BL_EBL + (16 * w + 4 * lq) * 4);
              const bf16x8 ka0 = ldfrag(buf + BL_KH, 16 * w + l15, S64, (8 * lq) * 2), ka1 = ldfrag(buf + BL_KH, 16 * w + l15, S64, (8 * lq + 32) * 2);
#pragma unroll
              for (int tv = 0; tv < 4; ++tv) { S[tv] = S[tv] * eb;
                  S[tv] = __builtin_amdgcn_mfma_f32_16x16x32_bf16(ka0, ldfrag(vt, 16 * tv + l15, S64, (8 * lq) * 2), S[tv], 0, 0, 0);
                  S[tv] = __builtin_amdgcn_mfma_f32_16x16x32_bf16(ka1, ldfrag(vt, 16 * tv + l15, S64, (8 * lq + 32) * 2), S[tv], 0, 0, 0);
                  *(LAS v2u*)(stn + (16 * tv + l15) * S128 + (16 * w + 4 * lq) * 2) = (v2u){pk2(S[tv][0], S[tv][1]), pk2(S[tv][2], S[tv][3])}; } }
          }
        }
#undef SCAN_LD
#undef SCAN_ST
#undef SCAN_ROW0
        asm volatile("s_waitcnt vmcnt(0)" ::: "memory");
#undef SCAN_CIDX
    }
    __syncthreads();
}

__device__ __forceinline__ void p4_readout(LAS unsigned char* lds_, const Params& p) {
    const Frame F = mk_frame(lds_);
    const bf16* OF = (const bf16*)(p.ws + WS_OF); const bf16* OB = (const bf16*)(p.ws + WS_OB); const bf16* SR = (const bf16*)(p.ws + WS_SR); bf16* Y = (bf16*)(p.ws + WS_Y);
    const int gw = F.bid * NWAVES + F.wave, NGW = F.G * NWAVES;
    f32x4 g[8];
#pragma unroll
    for (int h = 0; h < 8; ++h) g[h] = *(const f32x4*)(p.in[I_GNG] + h * DV + 4 * F.lane);
    for (int r = gw; r < M; r += NGW) {
        v2u a[8], b[8], c[8];
#pragma unroll
        for (int h = 0; h < 8; ++h) { const size_t o = (size_t)r * VALW + h * DV + 4 * F.lane; a[h] = __builtin_nontemporal_load((const v2u*)(OF + o)); b[h] = __builtin_nontemporal_load((const v2u*)(OB + o)); c[h] = __builtin_nontemporal_load((const v2u*)(SR + o)); }
#pragma unroll
        for (int h = 0; h < 8; ++h) {
            const float o0 = bf_lo(a[h].x) + bf_lo(b[h].x), o1 = bf_hi(a[h].x) + bf_hi(b[h].x), o2 = bf_lo(a[h].y) + bf_lo(b[h].y), o3 = bf_hi(a[h].y) + bf_hi(b[h].y);
            const float rstd = rsqrtf(wave_sum((o0 * o0 + o1 * o1) + (o2 * o2 + o3 * o3)) * (1.0f / DV) + EPS);
            v2u w; w.x = pk2(o0 * rstd * g[h][0] * bf_lo(c[h].x), o1 * rstd * g[h][1] * bf_hi(c[h].x)); w.y = pk2(o2 * rstd * g[h][2] * bf_lo(c[h].y), o3 * rstd * g[h][3] * bf_hi(c[h].y));
            *(v2u*)(Y + (size_t)r * D + h * DV + 4 * F.lane) = w; }
    }
}

__device__ __forceinline__ void p6_rows(LAS unsigned char* lds_, const Params& p) {
    const Frame F = mk_frame(lds_);
    LAS float* cA = (LAS float*)F.lds; LAS float* cB = cA + D; LAS float* cC = cB + D;
    const float* mod = (const float*)(p.ws + WS_MOD); bf16* A1 = (bf16*)(p.ws + WS_A1); const bf16* MIX = (const bf16*)(p.ws + WS_MIX); const float* ssq = (const float*)(p.ws + WS_SSQ);
    const int per = (M + F.G - 1) / F.G; int r0 = F.bid * per; const int rend = (r0 + per < M) ? r0 + per : M;
    while (r0 < rend) {
        const int bb = r0 / SEQ; const int bend = (bb + 1) * SEQ; const int r1 = rend < bend ? rend : bend; const float* mb = mod + (size_t)bb * NMOD * D;
        __syncthreads();
        { float l_[8][5];
#pragma unroll
          for (int j = 0; j < 8; ++j) { const int c = F.tid + NTHR * j; l_[j][0] = mb[2 * D + c]; l_[j][1] = p.in[I_POST1][c]; l_[j][2] = p.in[I_PRE2][c]; l_[j][3] = mb[4 * D + c]; l_[j][4] = mb[3 * D + c]; }
#pragma unroll
          for (int j = 0; j < 8; ++j) { const int c = F.tid + NTHR * j; cA[c] = l_[j][0] * l_[j][1]; cB[c] = l_[j][2] * (1.0f + l_[j][3]); cC[c] = l_[j][4]; } }
        __syncthreads();
        for (int r = r0 + F.wave; r < r1; r += NWAVES) {
            const float rstd1 = rsqrtf(wave_sum(ssq[(size_t)r * 64 + F.lane]) * (1.0f / D) + EPS);
            const float* xr = p.in[I_X] + (size_t)r * D; const bf16* mr = MIX + (size_t)r * D;
            f32x4 v[16]; float ss = 0.f;
#pragma unroll
            for (int jg = 0; jg < 16; jg += 8) {
                v2u m2[8];
#pragma unroll
                for (int j = 0; j < 8; ++j) { v[jg + j] = __builtin_nontemporal_load((const f32x4*)(xr + 256 * (jg + j) + 4 * F.lane)); m2[j] = __builtin_nontemporal_load((const v2u*)(mr + 256 * (jg + j) + 4 * F.lane)); }
#pragma unroll
                for (int j = 0; j < 8; ++j) { const f32x4 a = *(LAS f32x4*)(cA + 256 * (jg + j) + 4 * F.lane);
                    const f32x4 mx = (f32x4){bf_lo(m2[j].x), bf_hi(m2[j].x), bf_lo(m2[j].y), bf_hi(m2[j].y)};
                    const f32x4 t = v[jg + j] + a * mx * rstd1; v[jg + j] = t; ss += (t[0] * t[0] + t[1] * t[1]) + (t[2] * t[2] + t[3] * t[3]);
                    }
                asm volatile("" ::: "memory");
            }
            const float rstd2 = rsqrtf(wave_sum(ss) * (1.0f / D) + EPS);
            bf16* hrow = A1 + (size_t)r * D;
#pragma unroll
            for (int j = 0; j < 16; ++j) { const f32x4 b = *(LAS f32x4*)(cB + 256 * j + 4 * F.lane), c = *(LAS f32x4*)(cC + 256 * j + 4 * F.lane); const f32x4 o = v[j] * rstd2 * b + c;
                v2u w; w.x = pk2(o[0], o[1]); w.y = pk2(o[2], o[3]); *(v2u*)(hrow + 256 * j + 4 * F.lane) = w; if ((j & 3) == 3) asm volatile("" ::: "memory"); }
        }
        r0 = r1;
    }
    __syncthreads();
}
__device__ __forceinline__ void p9_rows(LAS unsigned char* lds_, const Params& p) {
    const Frame F = mk_frame(lds_);
    LAS float* cA = (LAS float*)F.lds; LAS float* cB = cA + D;
    const float* mod = (const float*)(p.ws + WS_MOD); const bf16* MIX = (const bf16*)(p.ws + WS_MIX); const bf16* MLP = (const bf16*)(p.ws + WS_MLP); const float* ssq1 = (const float*)(p.ws + WS_SSQ); const float* ssq2 = (const float*)(p.ws + WS_SSQ2);
    const int per = (M + F.G - 1) / F.G; int r0 = F.bid * per; const int rend = (r0 + per < M) ? r0 + per : M;
    while (r0 < rend) {
        const int bb = r0 / SEQ; const int bend = (bb + 1) * SEQ; const int r1 = rend < bend ? rend : bend; const float* mb = mod + (size_t)bb * NMOD * D;
        __syncthreads();
        { float l_[8][4];
#pragma unroll
          for (int j = 0; j < 8; ++j) { const int c = F.tid + NTHR * j; l_[j][0] = mb[2 * D + c]; l_[j][1] = p.in[I_POST1][c]; l_[j][2] = mb[5 * D + c]; l_[j][3] = p.in[I_POST2][c]; }
#pragma unroll
          for (int j = 0; j < 8; ++j) { const int c = F.tid + NTHR * j; cA[c] = l_[j][0] * l_[j][1]; cB[c] = l_[j][2] * l_[j][3]; } }
        __syncthreads();
        for (int r = r0 + F.wave; r < r1; r += NWAVES) {
            const float rstd1 = rsqrtf(wave_sum(ssq1[(size_t)r * 64 + F.lane]) * (1.0f / D) + EPS), rstd2 = rsqrtf(wave_sum(ssq2[(size_t)r * 64 + F.lane]) * (1.0f / D) + EPS);
            const float* xr = p.in[I_X] + (size_t)r * D; const bf16* mr = MIX + (size_t)r * D; const bf16* lr = MLP + (size_t)r * D; float* orow = p.out + (size_t)r * D;
#pragma unroll
            for (int jg = 0; jg < 16; jg += 8) {
                f32x4 xv[8]; v2u m2[8], l2[8];
#pragma unroll
                for (int j = 0; j < 8; ++j) { const int c = 256 * (jg + j) + 4 * F.lane; xv[j] = __builtin_nontemporal_load((const f32x4*)(xr + c)); m2[j] = __builtin_nontemporal_load((const v2u*)(mr + c)); l2[j] = __builtin_nontemporal_load((const v2u*)(lr + c)); }
#pragma unroll
                for (int j = 0; j < 8; ++j) { const int c = 256 * (jg + j) + 4 * F.lane; const f32x4 a = *(LAS f32x4*)(cA + c), b = *(LAS f32x4*)(cB + c);
                    const f32x4 mx = (f32x4){bf_lo(m2[j].x), bf_hi(m2[j].x), bf_lo(m2[j].y), bf_hi(m2[j].y)}, lx = (f32x4){bf_lo(l2[j].x), bf_hi(l2[j].x), bf_lo(l2[j].y), bf_hi(l2[j].y)};
                    const f32x4 x1 = xv[j] + a * mx * rstd1;
                    *(f32x4*)(orow + c) = x1 + b * lx * rstd2; }
                asm volatile("" ::: "memory");
            }
        }
        r0 = r1;
    }
}

__global__ void __launch_bounds__(NTHR, 2) dit_fwd(Params p) {
    extern __shared__ __attribute__((aligned(16))) unsigned char lds_raw[];
    LAS unsigned char* lds = (LAS unsigned char*)lds_raw; const int G = gridDim.x, bid = blockIdx.x;
    volatile LAS unsigned* MISC = (volatile LAS unsigned*)(lds + LDS_CTL_OFF);
    if (threadIdx.x < 64) MISC[threadIdx.x] = 0u;
    __syncthreads();
    gu32* ctl = (gu32*)(p.ws + WS_CTL);
    XcdBarrier bar = xcd_barrier_post((unsigned*)(ctl + CW_BAR), MISC + 8);
    unsigned char* ws = p.ws;

    p0_adaln(lds, p);
    p0_prologue(lds, p);
    xcd_barrier(bar);
    p1_rows(lds, p);
    xcd_barrier(bar);
    {
        pg8::Gemm g{(const pg8::bf16_t*)(ws + WS_A1), (const pg8::bf16_t*)(ws + WS_WIN), MT, IN_PAD, D};
        pg8::InOrder S{G, bid};
        pg8::EpiIn E{(pg8::bf16_t*)(ws + WS_Q), (pg8::bf16_t*)(ws + WS_KB), (pg8::bf16_t*)(ws + WS_V), (pg8::bf16_t*)(ws + WS_SR), (pg8::bf16_t*)(ws + WS_U), (pg8::bf16_t*)(ws + WS_VV), (float*)(ws + WS_LR), (float*)(ws + WS_SGSTAT), 0.08838834764831845f};
        pg8::gemm_phase<pg8::EpiIn, pg8::InOrder, true, true>(lds, g, S, E);
    }
    xcd_barrier(bar);
    {
        pg8::Gemm g{(const pg8::bf16_t*)(ws + WS_A1), (const pg8::bf16_t*)(ws + WS_WIN), MT, IN_PAD, D};
        pg8::TailOrder S{G, bid};
        pg8::EpiIn E{(pg8::bf16_t*)(ws + WS_Q), (pg8::bf16_t*)(ws + WS_KB), (pg8::bf16_t*)(ws + WS_V), (pg8::bf16_t*)(ws + WS_SR), (pg8::bf16_t*)(ws + WS_U), (pg8::bf16_t*)(ws + WS_VV), (float*)(ws + WS_LR), (float*)(ws + WS_SGSTAT), 0.08838834764831845f};
        pg8::gemm_phase<pg8::EpiIn, pg8::TailOrder, true, true>(lds, g, S, E);
    }
    p3_sg(lds, p);
    xcd_barrier(bar);
    p3_gla_pre(lds, p);
    xcd_barrier(bar);
    p3_gla_scan(lds, p);
    xcd_barrier(bar);
    p4_readout(lds, p);
    xcd_barrier(bar);
    {
        pg8::Gemm g{(const pg8::bf16_t*)(ws + WS_Y), (const pg8::bf16_t*)(ws + WS_WO), M, D, D};
        pg8::StaticOrder S; S.init(M, D, G, bid);
        pg8::EpiAct<0, 1> E{(pg8::bf16_t*)(ws + WS_MIX), D, (float*)(ws + WS_SSQ)};
        pg8::gemm_phase<pg8::EpiAct<0, 1>, pg8::StaticOrder, true, true>(lds, g, S, E);
    }
    xcd_barrier(bar);
    p6_rows(lds, p);
    xcd_barrier(bar);
    {
        pg8::Gemm g{(const pg8::bf16_t*)(ws + WS_A1), (const pg8::bf16_t*)(ws + WS_W1), M, FF, D};
        pg8::StaticOrder S; S.init(M, FF, G, bid);
        pg8::EpiAct<3, 0> E{(pg8::bf16_t*)(ws + WS_HMID), FF, nullptr};
        pg8::gemm_phase<pg8::EpiAct<3, 0>, pg8::StaticOrder, true, true>(lds, g, S, E);
    }
    xcd_barrier(bar);
    {
        pg8::Gemm g{(const pg8::bf16_t*)(ws + WS_HMID), (const pg8::bf16_t*)(ws + WS_W2), M, D, FF};
        pg8::StaticOrder S; S.init(M, D, G, bid);
        pg8::EpiAct<0, 1> E{(pg8::bf16_t*)(ws + WS_MLP), D, (float*)(ws + WS_SSQ2)};
        pg8::gemm_phase<pg8::EpiAct<0, 1>, pg8::StaticOrder, true, true>(lds, g, S, E);
    }
    xcd_barrier(bar);
    p9_rows(lds, p);
}

extern "C" void kernel_launch(void* const* d_in, const int* in_sizes, int n_in, void* d_out, int out_size, void* d_ws, size_t ws_size, hipStream_t stream) {
    static int grid = 0;
    if (grid == 0) {
        if (n_in != 23 || in_sizes[0] != M * D || out_size != M * D || ws_size < WS_END2) { fprintf(stderr, "kernel_launch: unexpected shapes (n_in %d, in0 %d, out %d, ws %zu); nothing launched\n", n_in, n_in > 0 ? in_sizes[0] : -1, out_size, ws_size); grid = -1; return; }
        int dev = 0, cus = 0, per_cu = 0;
        if (hipGetDevice(&dev) != hipSuccess || hipDeviceGetAttribute(&cus, hipDeviceAttributeMultiprocessorCount, dev) != hipSuccess) { grid = -1; return; }
        if (hipFuncSetAttribute((const void*)dit_fwd, hipFuncAttributeMaxDynamicSharedMemorySize, LDS_BYTES) != hipSuccess) { fprintf(stderr, "kernel_launch: hipFuncSetAttribute failed\n"); grid = -1; return; }
        if (hipOccupancyMaxActiveBlocksPerMultiprocessor(&per_cu, (const void*)dit_fwd, NTHR, LDS_BYTES) != hipSuccess || per_cu < 1) { fprintf(stderr, "kernel_launch: occupancy query reports %d blocks per CU\n", per_cu); }
        (void)hipGetLastError();
        grid = cus;
    }
    if (grid < 0) return;
    if (hipMemsetAsync((char*)d_ws + WS_CTL, 0, CTL_ZERO_BYTES, stream) != hipSuccess) return;
    Params a{};
    for (int i = 0; i < 23; ++i) a.in[i] = (const float*)d_in[i];
    a.out = (float*)d_out; a.ws = (unsigned char*)d_ws;
    hipLaunchKernelGGL(dit_fwd, dim3(grid), dim3(NTHR), LDS_BYTES, stream, a);
}
```

```cpp
#include <hip/hip_runtime.h>
#include <cstdio>
#include <cstdint>
namespace pg8 {
#define PG8_LAS __attribute__((address_space(3)))
typedef unsigned short bf16_t;
typedef short bf16x8 __attribute__((ext_vector_type(8)));
typedef float f32x4 __attribute__((ext_vector_type(4)));
typedef unsigned u32x4 __attribute__((ext_vector_type(4)));
constexpr int BM = 256, BK = 64, HALF = 128, HTB = HALF * BK * 2  , STAGE_BYTES = 8 * HTB, NXCD = 8, WGM = 8;

__host__ __device__ __forceinline__ int lds_byte(int r, int c) { const int st = (r >> 4) * 2 + (c >> 5), rr = r & 15, cc = c & 31, ob = rr * 64 + cc * 2; return st * 1024 + (ob ^ (((ob >> 9) & 1) << 5)); }
__host__ __device__ __forceinline__ void stage_rc(int b, int& R, int& C) { const int st = b / 1024, sb = b % 1024, swz = sb ^ (((sb >> 9) & 1) << 5); R = (st >> 1) * 16 + swz / 64; C = (st & 1) * 32 + (swz % 64) / 2; }
__host__ __device__ __forceinline__ int perm32(int rho) { const int n = rho >> 4, i = rho & 15; return 8 * (i >> 2) + 4 * n + (i & 3); }

struct Unit { int pm, pn; };
struct Gemm { const bf16_t* A; const bf16_t* Bt; int M, N, K; };

struct StaticOrder {
    int nM, nN, nwg, G, c;
    __host__ __device__ void init(int M, int N, int G_, int c_) { nM = M / BM; nN = N / BM; nwg = nM * nN; G = G_; c = c_; }
    __host__ __device__ bool next(int i, Unit& u) const {
        const long L = (long)i * G + c; if (L >= nwg) return false;
        int wgid = (int)L; { const int q = nwg / NXCD, r = nwg % NXCD, xcd = wgid % NXCD, off = wgid / NXCD; wgid = (xcd < r ? xcd * (q + 1) : r * (q + 1) + (xcd - r) * q) + off; }
        const int nig = WGM * nN, gid = wgid / nig, fm = gid * WGM, gsz = (nM - fm) < WGM ? (nM - fm) : WGM;
        u.pm = fm + ((wgid % nig) % gsz); u.pn = (wgid % nig) / gsz; return true;
    }
    __device__ __forceinline__ void a_ready(const Unit&) const {}
    __device__ __forceinline__ void done(const Unit&) const {}
};

__device__ __forceinline__ unsigned cvt_pk_bf16(float lo, float hi) { unsigned r; asm volatile("v_cvt_pk_bf16_f32 %0, %1, %2" : "=v"(r) : "v"(lo), "v"(hi)); return r; }
typedef float f32x2 __attribute__((ext_vector_type(2)));
__device__ __forceinline__ f32x2 gelu_pk(f32x2 v) {
    const f32x2 av = __builtin_elementwise_abs(v), d = av * 0.2316418882f + 1.0f;
    f32x2 t; t.x = __builtin_amdgcn_rcpf(d.x); t.y = __builtin_amdgcn_rcpf(d.y);
    f32x2 q = t * 0.5307027145f + (-0.7265760135f); q = q * t + 0.7107068705f; q = q * t + (-0.142248368f); q = q * t + 0.127414796f; q = q * t;
    const f32x2 s = (v * v) * (-0.72134752044f);
    f32x2 e; e.x = __builtin_amdgcn_exp2f(s.x); e.y = __builtin_amdgcn_exp2f(s.y);
    const f32x2 m = v * (q * e), r = v - m;
    f32x2 o; o.x = v.x < 0.f ? m.x : r.x; o.y = v.y < 0.f ? m.y : r.y; return o;
}

typedef unsigned u32x2 __attribute__((ext_vector_type(2)));
template <int ACT> __device__ __forceinline__ f32x4 act4(f32x4 v, float sc) {
    if (ACT == 0) return v * sc;
    if (ACT == 1) { f32x4 o;
#pragma unroll
        for (int j = 0; j < 4; ++j) o[j] = v[j] * __builtin_amdgcn_rcpf(1.0f + __expf(-v[j]));
        return o; }
    if (ACT == 2) { const f32x2 a = gelu_pk((f32x2){v[0], v[1]}), b = gelu_pk((f32x2){v[2], v[3]}); return (f32x4){a.x, a.y, b.x, b.y}; }
    { f32x4 o;
#pragma unroll
        for (int j = 0; j < 4; ++j) { const float t = v[j] > 0.f ? v[j] : 0.f; o[j] = t * t; }
        return o; }
}
template <int ACT, int STAT> __device__ __forceinline__ void store_tile(const f32x4 (&acc)[2][2][4][2], bf16_t* base, int ldc, int row0, int col0, float sc, float* stat, int slot, int fq) {
#pragma unroll
    for (int ai = 0; ai < 2; ++ai)
#pragma unroll
        for (int m = 0; m < 4; ++m) { const int row = row0 + ai * HALF + m * 16; bf16_t* rowp = base + (size_t)row * ldc + col0; float s1 = 0.f, s2 = 0.f;
#pragma unroll
            for (int bj = 0; bj < 2; ++bj) { const f32x4 v0 = act4<ACT>(acc[ai][bj][m][0], sc), v1 = act4<ACT>(acc[ai][bj][m][1], sc);
                if (STAT) { s1 += (v0[0] + v0[1]) + (v0[2] + v0[3]) + (v1[0] + v1[1]) + (v1[2] + v1[3]);
                            s2 += (v0[0] * v0[0] + v0[1] * v0[1]) + (v0[2] * v0[2] + v0[3] * v0[3]) + (v1[0] * v1[0] + v1[1] * v1[1]) + (v1[2] * v1[2] + v1[3] * v1[3]); }
                u32x4 w; w.x = cvt_pk_bf16(v0[0], v0[1]); w.y = cvt_pk_bf16(v0[2], v0[3]); w.z = cvt_pk_bf16(v1[0], v1[1]); w.w = cvt_pk_bf16(v1[2], v1[3]);
                *(u32x4*)(rowp + bj * HALF) = w; }
            if (STAT) { s2 += __shfl_xor(s2, 16); s2 += __shfl_xor(s2, 32);
                if (STAT == 2) { s1 += __shfl_xor(s1, 16); s1 += __shfl_xor(s1, 32); if (fq == 0) *(f32x2*)(stat + ((size_t)row * 32 + slot) * 2) = (f32x2){s1, s2}; }
                else { if (fq == 0) stat[(size_t)row * 64 + slot] = s2; } } }
}
struct EpiIn {
    static constexpr bool PERM = true, AFTER_DRAIN = false;
    bf16_t *Q, *Kb, *V, *SR, *U, *VV; float* LR; float* sgstat; float qscale;
    __device__ __forceinline__ void operator()(const f32x4 (&acc)[2][2][4][2], const Unit& u, int wr, int wc, int fr, int fq) const {
        const int pn = u.pn, row0 = u.pm * BM + wr * 64 + fr, cw = wc * 32 + 8 * fq;
        if (pn < 4)       store_tile<0, 0>(acc, Q, 1024, row0, pn * 256 + cw, qscale, nullptr, 0, fq);
        else if (pn < 8)  store_tile<0, 0>(acc, Kb, 1024, row0, (pn - 4) * 256 + cw, 1.0f, nullptr, 0, fq);
        else if (pn < 16) store_tile<0, 0>(acc, V, 2048, row0, (pn - 8) * 256 + cw, 1.0f, nullptr, 0, fq);
        else if (pn < 24) store_tile<1, 0>(acc, SR, 2048, row0, (pn - 16) * 256 + cw, 1.0f, nullptr, 0, fq);
        else if (pn < 32) store_tile<2, 0>(acc, U, 2048, row0, (pn - 24) * 256 + cw, 1.0f, nullptr, 0, fq);
        else if (pn < 40) store_tile<2, 2>(acc, VV, 2048, row0, (pn - 32) * 256 + cw, 1.0f, sgstat, (pn - 32) * 4 + wc, fq);
        else if (wc == 0) {
#pragma unroll
            for (int ai = 0; ai < 2; ++ai)
#pragma unroll
                for (int m = 0; m < 4; ++m) { float* p = LR + (size_t)(row0 + ai * HALF + m * 16) * 32 + 8 * fq; *(f32x4*)p = acc[ai][0][m][0]; *(f32x4*)(p + 4) = acc[ai][0][m][1]; }
        }
    }
};
struct InOrder {
    int G, c;
    __device__ bool next(int i, Unit& u) const {
        const int L = i * G + c; constexpr int nM = 64, nN = 40, nwg = nM * nN;
        if (L >= nwg) return false;
        int wgid = L; { const int q = nwg / NXCD, xcd = wgid % NXCD, off = wgid / NXCD; wgid = xcd * q + off; }
        const int nig = WGM * nN, gid = wgid / nig, fm = gid * WGM;
        u.pm = fm + ((wgid % nig) % WGM); u.pn = (wgid % nig) / WGM; return true;
    }
    __device__ __forceinline__ void a_ready(const Unit&) const {}
    __device__ __forceinline__ void done(const Unit&) const {}
};
constexpr int N_TAIL = 116;
struct TailOrder {
    int G, c;
    __device__ bool next(int i, Unit& u) const {
        const int L = i * G + c; if (L >= N_TAIL) return false;
        if (L < 68) { u.pm = L; u.pn = 40; } else { const int x = L - 68; u.pm = 64 + x / 12; u.pn = 4 + x % 12; }
        return true;
    }
    __device__ __forceinline__ void a_ready(const Unit&) const {}
    __device__ __forceinline__ void done(const Unit&) const {}
};
template <int ACT, int STAT> struct EpiAct {
    static constexpr bool PERM = true, AFTER_DRAIN = false;
    bf16_t* O; int ldc; float* stat;
    __device__ __forceinline__ void operator()(const f32x4 (&acc)[2][2][4][2], const Unit& u, int wr, int wc, int fr, int fq) const {
        store_tile<ACT, STAT>(acc, O, ldc, u.pm * BM + wr * 64 + fr, u.pn * BM + wc * 32 + 8 * fq, 1.0f, stat, u.pn * 4 + wc, fq);
    }
};
template <class Epi, class Sched, bool ALIGN_EPI = false, bool SP2 = false>
__device__ __forceinline__ void gemm_phase(PG8_LAS unsigned char* lds, const Gemm g, const Sched& S, const Epi& E) {
    int tid_ = threadIdx.x; asm volatile("" : "+v"(tid_));
    const int tid = tid_, wid = __builtin_amdgcn_readfirstlane(tid >> 6), lane = tid & 63, wr = wid >> 2, wc = wid & 3, fr = lane & 15, fq = lane >> 4;
    const int K = g.K, nt = K / BK;
    unsigned voffA[2], voffB[2];
#pragma unroll
    for (int i = 0; i < 2; ++i) { int R, C; stage_rc(tid * 16 + i * 8192, R, C); const int Rb = Epi::PERM ? ((R & ~31) + perm32(R & 31)) : R;
        voffA[i] = (unsigned)(R * K + C) * 2u; voffB[i] = (unsigned)(Rb * K + C) * 2u; }
    const size_t kstep = (size_t)(BK * 2);
    const size_t hstep = (size_t)HALF * K * 2;
    const size_t tstep = 2 * hstep;
    const unsigned ldsw = (unsigned)wid * 1024u;
    const int aoff = lds_byte(wr * 64 + fr, fq * 8), boff = lds_byte(wc * 32 + fr, fq * 8);
#define PG8_SA(b, h) (((b) * 2 + (h)) * HTB)
#define PG8_SB(b, h) ((4 + (b) * 2 + (h)) * HTB)
#define PG8_STAGE(bufoff, gbase, voff) do { _Pragma("unroll") for (int _i = 0; _i < 2; ++_i) \
        __builtin_amdgcn_global_load_lds((const unsigned*)((const char*)(gbase) + (voff)[_i]), (PG8_LAS unsigned*)(lds + (bufoff) + ldsw + _i * 8192), 16, 0, 0); } while (0)
#define PG8_LDA(dst, b, h) do { _Pragma("unroll") for (int m = 0; m < 4; ++m) _Pragma("unroll") for (int k = 0; k < 2; ++k) dst[m][k] = *(const PG8_LAS bf16x8*)(lds + PG8_SA(b, h) + aoff + m * 2048 + k * 1024); } while (0)
#define PG8_LDB(dst, b, h) do { _Pragma("unroll") for (int n = 0; n < 2; ++n) _Pragma("unroll") for (int k = 0; k < 2; ++k) dst[n][k] = *(const PG8_LAS bf16x8*)(lds + PG8_SB(b, h) + boff + n * 2048 + k * 1024); } while (0)
#define PG8_MMA(ai, bj, At, Bt) do { __builtin_amdgcn_s_setprio(1); _Pragma("unroll") for (int m = 0; m < 4; ++m) _Pragma("unroll") for (int n = 0; n < 2; ++n) _Pragma("unroll") for (int k = 0; k < 2; ++k) \
        acc[ai][bj][m][n] = __builtin_amdgcn_mfma_f32_16x16x32_bf16(Bt[n][k], At[m][k], acc[ai][bj][m][n], 0, 0, 0); __builtin_amdgcn_s_setprio(0); } while (0)
#define PG8_WAIT_V(n) asm volatile("s_waitcnt vmcnt(" #n ")" ::: "memory")
#define PG8_WAIT_L(n) asm volatile("s_waitcnt lgkmcnt(" #n ")" ::: "memory")
#define PG8_BAR __builtin_amdgcn_s_barrier()
#define PG8_SCHED __builtin_amdgcn_sched_barrier(0)
    Unit cur, nxt; int ui = 0;
    if (!S.next(0, cur)) return;
    f32x4 acc[2][2][4][2];
#pragma unroll
    for (int a = 0; a < 2; ++a)
#pragma unroll
        for (int b = 0; b < 2; ++b)
#pragma unroll
            for (int m = 0; m < 4; ++m)
#pragma unroll
                for (int n = 0; n < 2; ++n) acc[a][b][m][n] = (f32x4){0.f, 0.f, 0.f, 0.f};
    bf16x8 At[4][2], B0[2][2], B1[2][2];
    const char* cA = (const char*)g.A + (size_t)cur.pm * tstep; const char* cB = (const char*)g.Bt + (size_t)cur.pn * tstep;
    S.a_ready(cur);
    if constexpr (SP2) {
        PG8_STAGE(PG8_SB(0, 0), cB, voffB); PG8_STAGE(PG8_SB(0, 1), cB + hstep, voffB); PG8_STAGE(PG8_SA(0, 0), cA, voffA); PG8_STAGE(PG8_SA(0, 1), cA + hstep, voffA);
        if (wr == 1) PG8_BAR;
        PG8_WAIT_V(2); PG8_BAR;
        PG8_STAGE(PG8_SB(1, 0), cB + kstep, voffB); PG8_STAGE(PG8_SA(1, 0), cA + kstep, voffA); PG8_STAGE(PG8_SB(1, 1), cB + hstep + kstep, voffB);
        PG8_WAIT_V(6); PG8_BAR;
    } else {
        PG8_STAGE(PG8_SB(0, 0), cB, voffB); PG8_STAGE(PG8_SA(0, 0), cA, voffA); PG8_STAGE(PG8_SB(0, 1), cB + hstep, voffB); PG8_STAGE(PG8_SA(0, 1), cA + hstep, voffA);
        if (wr == 1) PG8_BAR;
        PG8_WAIT_V(4); PG8_BAR;
        PG8_STAGE(PG8_SB(1, 0), cB + kstep, voffB); PG8_STAGE(PG8_SA(1, 0), cA + kstep, voffA); PG8_STAGE(PG8_SB(1, 1), cB + hstep + kstep, voffB);
        PG8_WAIT_V(6); PG8_BAR;
    }
    for (;;) {
        const bool has_next = S.next(ui + 1, nxt);
        const char* nA = has_next ? (const char*)g.A + (size_t)nxt.pm * tstep : cA; const char* nB = has_next ? (const char*)g.Bt + (size_t)nxt.pn * tstep : cB;
        for (int t = 0; t < nt; t += 2) {
            const bool last = (t == nt - 2);
            const char* a1 = cA + (size_t)(t + 1) * kstep;
            const char* a2 = last ? nA : cA + (size_t)(t + 2) * kstep; const char* b2 = last ? nB : cB + (size_t)(t + 2) * kstep;
            const char* a3 = a2 + kstep; const char* b3 = b2 + kstep;
            if (last && has_next) S.a_ready(nxt);
            if constexpr (SP2) {
            PG8_LDB(B0, 0, 0); PG8_LDB(B1, 0, 1); PG8_SCHED; PG8_LDA(At, 0, 0); PG8_STAGE(PG8_SA(1, 1), a1 + hstep, voffA);
            PG8_WAIT_V(8); PG8_WAIT_L(0); PG8_BAR; PG8_MMA(0, 0, At, B0); PG8_MMA(0, 1, At, B1); PG8_BAR; PG8_SCHED;
            PG8_LDA(At, 0, 1); PG8_STAGE(PG8_SB(0, 0), b2, voffB); PG8_STAGE(PG8_SB(0, 1), b2 + hstep, voffB); PG8_STAGE(PG8_SA(0, 0), a2, voffA);
            PG8_WAIT_V(8); PG8_WAIT_L(0); PG8_BAR; PG8_MMA(1, 0, At, B0); PG8_MMA(1, 1, At, B1); PG8_BAR; PG8_SCHED;
            PG8_LDB(B0, 1, 0); PG8_LDB(B1, 1, 1); PG8_SCHED; PG8_LDA(At, 1, 0); PG8_STAGE(PG8_SA(0, 1), a2 + hstep, voffA);
            PG8_WAIT_V(8); PG8_WAIT_L(0); PG8_BAR; PG8_MMA(0, 0, At, B0); PG8_MMA(0, 1, At, B1); PG8_BAR; PG8_SCHED;
            PG8_LDA(At, 1, 1); PG8_STAGE(PG8_SB(1, 0), b3, voffB); PG8_STAGE(PG8_SB(1, 1), b3 + hstep, voffB); PG8_STAGE(PG8_SA(1, 0), a3, voffA);
            PG8_WAIT_V(8); PG8_WAIT_L(0); PG8_BAR; PG8_MMA(1, 0, At, B0); PG8_MMA(1, 1, At, B1); PG8_BAR; PG8_SCHED;
            } else {
            PG8_LDB(B0, 0, 0); PG8_SCHED; PG8_LDA(At, 0, 0); PG8_STAGE(PG8_SA(1, 1), a1 + hstep, voffA);
            PG8_WAIT_L(8); PG8_BAR; PG8_WAIT_L(0); PG8_MMA(0, 0, At, B0); PG8_BAR; PG8_SCHED;
            PG8_LDB(B1, 0, 1); PG8_STAGE(PG8_SB(0, 0), b2, voffB);
            PG8_BAR; PG8_WAIT_L(0); PG8_MMA(0, 1, At, B1); PG8_BAR;
            PG8_LDA(At, 0, 1); PG8_STAGE(PG8_SA(0, 0), a2, voffA);
            PG8_BAR; PG8_WAIT_L(0); PG8_MMA(1, 0, At, B0); PG8_BAR; PG8_SCHED;
            PG8_STAGE(PG8_SB(0, 1), b2 + hstep, voffB);
            PG8_WAIT_V(6); PG8_BAR; PG8_MMA(1, 1, At, B1); PG8_BAR;
            PG8_LDB(B0, 1, 0); PG8_SCHED; PG8_LDA(At, 1, 0); PG8_STAGE(PG8_SA(0, 1), a2 + hstep, voffA);
            PG8_WAIT_L(8); PG8_BAR; PG8_WAIT_L(0); PG8_MMA(0, 0, At, B0); PG8_BAR; PG8_SCHED;
            PG8_LDB(B1, 1, 1); PG8_STAGE(PG8_SB(1, 0), b3, voffB);
            PG8_BAR; PG8_WAIT_L(0); PG8_MMA(0, 1, At, B1); PG8_BAR;
            PG8_LDA(At, 1, 1); PG8_STAGE(PG8_SA(1, 0), a3, voffA);
            PG8_BAR; PG8_WAIT_L(0); PG8_MMA(1, 0, At, B0); PG8_BAR; PG8_SCHED;
            PG8_STAGE(PG8_SB(1, 1), b3 + hstep, voffB);
            PG8_WAIT_V(6); PG8_BAR; PG8_MMA(1, 1, At, B1); PG8_BAR;
            }
        }
        if constexpr (ALIGN_EPI) { if (wr == 0) PG8_BAR; }
        if constexpr (!Epi::AFTER_DRAIN) { E(acc, cur, wr, wc, fr, fq); S.done(cur); }
        if (!has_next) break;
#pragma unroll
        for (int a = 0; a < 2; ++a)
#pragma unroll
            for (int b = 0; b < 2; ++b)
#pragma unroll
                for (int m = 0; m < 4; ++m)
#pragma unroll
                    for (int n = 0; n < 2; ++n) acc[a][b][m][n] = (f32x4){0.f, 0.f, 0.f, 0.f};
        cur = nxt; cA = nA; cB = nB; ++ui;
        if constexpr (ALIGN_EPI) { if (wr == 1) PG8_BAR; }
    }
    PG8_WAIT_V(0);
    if constexpr (!ALIGN_EPI) { if (wr == 0) PG8_BAR; }
    PG8_BAR;
    if constexpr (Epi::AFTER_DRAIN) { E.fused(acc, cur, wr, wc, fr, fq, lds, wid, lane); S.done(cur); }
#undef PG8_SA
#undef PG8_SB
#undef PG8_STAGE
#undef PG8_LDA
#undef PG8_LDB
#undef PG8_MMA
#undef PG8_WAIT_V
#undef PG8_WAIT_L
#undef PG8_BAR
#undef PG8_SCHED
}
}

constexpr int NWAVES = 8, NTHR = 512;
constexpr int BATCH = 4, SEQ = 4096, D = 4096, CTXL = 256, M = BATCH * SEQ, MC = BATCH * CTXL, MT = M + MC;
constexpr int HEADS = 8, DK = 128, DV = 256, KEYW = 1024, VALW = 2048, LOWR = 16, SGW = 2048, SGG = 4, SGGW = 512, SGC = 128, FF = 16384, NMOD = 6;
constexpr int IN_COLS = 10272, IN_PAD = 10496;
constexpr int C_LF = 6144, C_SG = 6176;
constexpr int N_DEFER = 4096;
constexpr float EPS = 1e-6f;

constexpr size_t MiB = 1u << 20;
constexpr size_t WS_CTL = 0, CTL_ZERO_BYTES = 64 * 1024;
constexpr size_t WS_MOD = 1 * MiB;
constexpr size_t WS_ROPE = 2 * MiB;
constexpr size_t WS_SGSTAT = 3 * MiB;
constexpr size_t WS_SSQ = 7 * MiB, WS_SSQ2 = 11 * MiB;
constexpr size_t WS_WIN = 16 * MiB, WS_WO = 98 * MiB, WS_W1 = 130 * MiB, WS_W2 = 258 * MiB;
constexpr size_t WS_A1 = 386 * MiB;
constexpr size_t WS_Q = 522 * MiB, WS_KB = 554 * MiB, WS_V = 588 * MiB, WS_SR = 656 * MiB, WS_U = 720 * MiB, WS_VV = 784 * MiB, WS_LR = 848 * MiB, WS_OF = 851 * MiB, WS_OB = 915 * MiB, WS_Y = 979 * MiB;
constexpr size_t WS_HMID = 522 * MiB;
constexpr size_t WS_MIX = 1107 * MiB, WS_MLP = 1235 * MiB;
constexpr size_t WS_END = 1235 * MiB;
static_assert(WS_WIN + (size_t)IN_PAD * D * 2 <= WS_WO && WS_A1 + (size_t)MT * D * 2 <= WS_Q && WS_KB + (size_t)MT * KEYW * 2 <= WS_V && WS_V + (size_t)MT * VALW * 2 <= WS_SR && WS_LR + (size_t)MT * 32 * 4 <= WS_OF && WS_HMID + (size_t)M * FF * 2 <= WS_MIX && WS_Y + (size_t)M * D * 2 <= WS_MIX, "d_ws map");
constexpr int CW_BAR = 4096, CW_VB = 12288, CW_Q = 13312, CW_Q2 = 13824;

constexpr int LDS_CTL_OFF = 155648, LDS_BYTES = 159744;

#define GAS __attribute__((address_space(1)))
#define LAS __attribute__((address_space(3)))
typedef unsigned short bf16;
typedef unsigned v4u __attribute__((ext_vector_type(4)));
typedef unsigned v2u __attribute__((ext_vector_type(2)));
typedef float f32x4 __attribute__((ext_vector_type(4)));
typedef float f32x2 __attribute__((ext_vector_type(2)));
typedef short bf16x8 __attribute__((ext_vector_type(8)));
typedef GAS unsigned gu32;
#define LDS_WAIT() asm volatile("s_waitcnt lgkmcnt(0)" ::: "memory")
#define LDS_BARRIER() asm volatile("s_waitcnt lgkmcnt(0)\n\ts_barrier" ::: "memory")
__device__ __forceinline__ unsigned f2bf(float f) { unsigned u = __builtin_bit_cast(unsigned, f); return (u + 0x7fffu + ((u >> 16) & 1u)) >> 16; }
typedef __bf16 bf16x2_hw __attribute__((ext_vector_type(2)));
__device__ __forceinline__ unsigned pk2(float lo, float hi) { const f32x2 v = {lo, hi}; return __builtin_bit_cast(unsigned, __builtin_convertvector(v, bf16x2_hw)); }
__device__ __forceinline__ float bf_lo(unsigned w) { return __builtin_bit_cast(float, w << 16); }
__device__ __forceinline__ float bf_hi(unsigned w) { return __builtin_bit_cast(float, w & 0xffff0000u); }
__device__ __forceinline__ float bf1(bf16 h) { return __builtin_bit_cast(float, (unsigned)h << 16); }
__device__ __forceinline__ float wave_sum(float v) {
#pragma unroll
    for (int o = 1; o < 64; o <<= 1) v += __shfl_xor(v, o);
    return v;
}
__device__ __forceinline__ void st_global_b64(void* p, v2u v) { asm volatile("global_store_dwordx2 %0, %1, off\n\ts_nop 1" :: "v"(p), "v"(v) : "memory"); }
__device__ __forceinline__ void st_global_b128(void* p, v4u v) { asm volatile("global_store_dwordx4 %0, %1, off\n\ts_nop 1" :: "v"(p), "v"(v) : "memory"); }
#define XB_TMO      128
#define XB_XCNT(j)  (256  + 64 * (j))
#define XB_XSUB(j)  (1280 + 64 * (j))
#define XB_XGEN(j)  (2304 + 64 * (j))
#define XB_TOP      3328
#define XB_TOPGEN   3392
#define XCD_BAR_WORDS 3456
#define XB_SPIN_CAP (1u << 18)

__device__ __forceinline__ unsigned xb_ld(unsigned* p)              { return __hip_atomic_load(p, __ATOMIC_RELAXED, __HIP_MEMORY_SCOPE_AGENT); }
__device__ __forceinline__ unsigned xb_add(unsigned* p, unsigned v) { return __hip_atomic_fetch_add(p, v, __ATOMIC_RELAXED, __HIP_MEMORY_SCOPE_AGENT); }
__device__ __forceinline__ unsigned xb_xcc_id() { return (unsigned)__builtin_amdgcn_s_getreg((3 << 11) | 20) & 0xFu; }
#define XB_SPIN(cond, bar) do { unsigned _sp = 0; while (cond) { __builtin_amdgcn_s_sleep(1); \
    if ((++_sp & 255u) == 0u) { if (xb_ld(&(bar)[XB_TMO])) break; if (_sp > XB_SPIN_CAP) { atomicAdd(&(bar)[XB_TMO], 1u); break; } } } } while (0)

struct XcdBarrier {
    unsigned* bar; unsigned x;
    volatile LAS unsigned* st;
};

__device__ __forceinline__ XcdBarrier xcd_barrier_post(unsigned* bar, volatile LAS unsigned* st) {
    XcdBarrier b; b.bar = bar; b.x = xb_xcc_id(); b.st = st;
    if (threadIdx.x == 0) (void)xb_add(&bar[XB_XCNT(b.x)], 1u);
    return b;
}
__device__ __forceinline__ void xcd_barrier_complete(unsigned* bar, unsigned x, unsigned& nloc, unsigned& nx) {
    const unsigned G = gridDim.x * gridDim.y * gridDim.z;
    unsigned sum, cnt, mine, sp = 0u;
    for (;;) {
        sum = 0u; cnt = 0u; mine = 0u;
#pragma unroll
        for (unsigned j = 0; j < 16; ++j) { const unsigned c = xb_ld(&bar[XB_XCNT(j)]); sum += c; cnt += (c > 0u) ? 1u : 0u; mine = (j == x) ? c : mine; }
        if (sum == G) break;
        __builtin_amdgcn_s_sleep(1);
        if ((++sp & 255u) == 0u) { if (xb_ld(&bar[XB_TMO])) break; if (sp > XB_SPIN_CAP) { atomicAdd(&bar[XB_TMO], 1u); break; } }
    }
    nloc = mine > 0u ? mine : 1u; nx = cnt > 0u ? cnt : 1u;
}

__device__ __forceinline__ void xcd_barrier(const XcdBarrier& b) {
    asm volatile("s_waitcnt vmcnt(0)" ::: "memory");
    __syncthreads();
    if (threadIdx.x == 0) {
        unsigned* bar = b.bar;
        __builtin_amdgcn_s_waitcnt(0);
        unsigned nloc = b.st[0], nx = b.st[1];
        if (nloc == 0u) { xcd_barrier_complete(bar, b.x, nloc, nx); b.st[0] = nloc; b.st[1] = nx; }
        const unsigned old = xb_add(&bar[XB_XSUB(b.x)], 1u);
        const unsigned gen = old / nloc;
        if (old + 1u == (gen + 1u) * nloc) {
            __builtin_amdgcn_fence(__ATOMIC_RELEASE, "agent");
            asm volatile("s_waitcnt vmcnt(0)" ::: "memory");
            const unsigned og = xb_add(&bar[XB_TOP], 1u);
            const unsigned tg = og / nx;
            if (og + 1u == (tg + 1u) * nx) xb_add(&bar[XB_TOPGEN], 1u);
            else XB_SPIN(xb_ld(&bar[XB_TOPGEN]) == tg, bar);
            __builtin_amdgcn_fence(__ATOMIC_ACQUIRE, "agent");
            xb_add(&bar[XB_XGEN(b.x)], 1u);
            asm volatile("s_waitcnt vmcnt(0)" ::: "memory");
        } else {
            XB_SPIN(xb_ld(&bar[XB_XGEN(b.x)]) == gen, bar);
            __builtin_amdgcn_fence(__ATOMIC_ACQUIRE, "agent");
            asm volatile("s_waitcnt vmcnt(0)" ::: "memory");
        }
    }
    __syncthreads();
}

#define XB_GRP(j)  (4096 + 64 * (j))
#define XB_WAR     4608
template <int K, bool ARRIVE, bool WAITALL> __device__ __forceinline__ void grp_barrier(const XcdBarrier& b) {
    asm volatile("s_waitcnt vmcnt(0)" ::: "memory");
    __syncthreads();
    if (threadIdx.x == 0) {
        unsigned* bar = b.bar; const unsigned g = blockIdx.x & 7u;
        __builtin_amdgcn_s_waitcnt(0);
        __builtin_amdgcn_fence(__ATOMIC_RELEASE, "agent");
        asm volatile("s_waitcnt vmcnt(0)" ::: "memory");
        if (ARRIVE) (void)xb_add(&bar[XB_WAR], 1u);
        (void)xb_add(&bar[XB_GRP(g)], 1u);
        XB_SPIN(xb_ld(&bar[XB_GRP(g)]) < (unsigned)(K + 1) * 32u, bar);
        if (WAITALL) XB_SPIN(xb_ld(&bar[XB_WAR]) < gridDim.x, bar);
        __builtin_amdgcn_fence(__ATOMIC_ACQUIRE, "agent");
        asm volatile("s_waitcnt vmcnt(0)" ::: "memory");
    }
    __syncthreads();
}

struct Params { const float* in[23]; float* out; unsigned char* ws; };
struct Frame {
    LAS unsigned char* lds;
    int tid, lane, wave, G, bid;
};
__device__ __forceinline__ Frame mk_frame(LAS unsigned char* lds) { Frame F; int t = threadIdx.x; asm volatile("" : "+v"(t));
    F.lds = lds; F.tid = t; F.lane = t & 63; F.wave = __builtin_amdgcn_readfirstlane(t >> 6); F.G = gridDim.x; F.bid = blockIdx.x; return F; }
enum { I_X = 0, I_C, I_CTX, I_CCTX, I_WADA, I_BADA, I_PRE1, I_POST1, I_PRE2, I_POST2, I_WIN, I_WDF, I_BDF, I_WDB, I_BDB, I_GNG, I_SGLG, I_SGLB, I_WS, I_BS, I_WO, I_W1, I_W2 };

__device__ __forceinline__ void p0_transpose_item(const float* W, int K, int N, bf16* WT, int k0, int n0, int dst_row, LAS float* scr, int lane) {
    f32x4 v[16]; const int lr = lane >> 4, lc = (lane & 15) * 4;
#pragma unroll
    for (int i = 0; i < 16; ++i) v[i] = __builtin_nontemporal_load((const f32x4*)(W + (size_t)(k0 + 4 * i + lr) * N + n0 + lc));
#pragma unroll
    for (int i = 0; i < 16; ++i) { LAS float* d = scr + (4 * i + lr) * 65 + lc; d[0] = v[i][0]; d[1] = v[i][1]; d[2] = v[i][2]; d[3] = v[i][3]; }
    LDS_WAIT(); asm volatile("" ::: "memory");
    const int c = lane & 7;
#pragma unroll
    for (int j = 0; j < 8; ++j) { const int n = (lane >> 3) + 8 * j; const LAS float* s = scr + (8 * c) * 65 + n;
        v4u o; o.x = pk2(s[0 * 65], s[1 * 65]); o.y = pk2(s[2 * 65], s[3 * 65]); o.z = pk2(s[4 * 65], s[5 * 65]); o.w = pk2(s[6 * 65], s[7 * 65]);
        *(v4u*)(WT + (size_t)(dst_row + n) * K + k0 + 8 * c) = o; }
    LDS_WAIT(); asm volatile("" ::: "memory");
}
__device__ __forceinline__ float silu_f(float v) { return v / (1.0f + __expf(-v)); }

__device__ __forceinline__ void p0_adaln(LAS unsigned char* lds_, const Params& p) {
    const Frame F = mk_frame(lds_);
    unsigned char* ws = p.ws;
    {
        LAS float* sc = (LAS float*)F.lds;
        LAS float* red = (LAS float*)(F.lds + 81920);
        { f32x4 cv[10];
#pragma unroll
          for (int j = 0; j < 10; ++j) { const int i4 = F.tid + NTHR * j, r = i4 >> 10, k4 = i4 & 1023; cv[j] = *(const f32x4*)((r < 4 ? p.in[I_C] + r * D : p.in[I_CCTX]) + 4 * k4); }
#pragma unroll
          for (int j = 0; j < 10; ++j) { const int i4 = F.tid + NTHR * j; *(LAS f32x4*)(sc + 4 * i4) = (f32x4){silu_f(cv[j][0]), silu_f(cv[j][1]), silu_f(cv[j][2]), silu_f(cv[j][3])}; } }
        __syncthreads();
        const float* W = p.in[I_WADA]; const float* bA = p.in[I_BADA]; float* mod = (float*)(ws + WS_MOD);
        constexpr int NT = NMOD * D;
        for (int cb = F.bid; cb < NT / 96; cb += F.G) {
            const int r8 = F.lane >> 3, c = F.lane & 7;
            f32x4 a[5][3];
#pragma unroll
            for (int r = 0; r < 5; ++r)
#pragma unroll
                for (int q = 0; q < 3; ++q) a[r][q] = (f32x4){0.f, 0.f, 0.f, 0.f};
            const float* wp = W + (size_t)(F.wave * 512 + r8) * NT + cb * 96 + 4 * c;
            f32x4 wa[4][3], wb[4][3];
#define ADA_LD(Wv, it0) do { _Pragma("unroll") for (int u = 0; u < 4; ++u) { const float* wr = wp + (size_t)(8 * ((it0) + u)) * NT; Wv[u][0] = __builtin_nontemporal_load((const f32x4*)(wr)); Wv[u][1] = __builtin_nontemporal_load((const f32x4*)(wr + 32)); Wv[u][2] = __builtin_nontemporal_load((const f32x4*)(wr + 64)); } } while (0)
#define ADA_USE(Wv, it0) do { _Pragma("unroll") for (int u = 0; u < 4; ++u) { const int k = F.wave * 512 + 8 * ((it0) + u) + r8; \
                _Pragma("unroll") for (int r = 0; r < 5; ++r) { const float sv = sc[r * D + k]; a[r][0] += Wv[u][0] * sv; a[r][1] += Wv[u][1] * sv; a[r][2] += Wv[u][2] * sv; } } } while (0)
            ADA_LD(wa, 0);
#pragma unroll 1
            for (int it = 0; it < 64; it += 8) { ADA_LD(wb, it + 4); ADA_USE(wa, it); if (it + 8 < 64) ADA_LD(wa, it + 8); ADA_USE(wb, it + 4); }
#undef ADA_LD
#undef ADA_USE
#pragma unroll
            for (int r = 0; r < 5; ++r)
#pragma unroll
                for (int q = 0; q < 3; ++q)
#pragma unroll
                    for (int j = 0; j < 4; ++j) { float v = a[r][q][j]; v += __shfl_xor(v, 8); v += __shfl_xor(v, 16); v += __shfl_xor(v, 32); a[r][q][j] = v; }
            if (r8 == 0) {
#pragma unroll
                for (int r = 0; r < 5; ++r)
#pragma unroll
                    for (int q = 0; q < 3; ++q) *(LAS f32x4*)(red + (F.wave * 5 + r) * 96 + 32 * q + 4 * c) = a[r][q]; }
            __syncthreads();
            if (F.tid < 480) { const int r = F.tid / 96, n = F.tid % 96; float s = bA[cb * 96 + n];
#pragma unroll
                for (int w = 0; w < 8; ++w) s += red[(w * 5 + r) * 96 + n];
                mod[(size_t)r * NT + cb * 96 + n] = s; }
            __syncthreads();
        }
        __syncthreads();
    }
}
__device__ __forceinline__ void p0_prologue(LAS unsigned char* lds_, const Params& p) {
    const Frame F = mk_frame(lds_);
    unsigned char* ws = p.ws;
    if (F.bid == 0) {
        float* tab = (float*)(ws + WS_ROPE);
        for (int i = F.tid; i < 2048; i += NTHR) { const int pos = i >> 5, j = i & 31;
            const float inv = exp2f(-(float)j * (13.287712379549449f / 32.0f));
            const float ang = (float)pos * inv; float f = ang * 0.15915494309189535f; f -= floorf(f);
            tab[2 * i] = __builtin_amdgcn_cosf(f); tab[2 * i + 1] = __builtin_amdgcn_sinf(f); }
    }
    { v4u* z = (v4u*)(ws + WS_WIN + (size_t)IN_COLS * D * 2); const size_t n = (size_t)(IN_PAD - IN_COLS) * D * 2 / 16;
      for (size_t i = (size_t)F.bid * NTHR + F.tid; i < n; i += (size_t)F.G * NTHR) z[i] = (v4u){0u, 0u, 0u, 0u}; }
    {
        LAS float* scr = (LAS float*)(F.lds + F.wave * 16896);
        constexpr int NB_IN = 96 + 64 + 1;
        constexpr int I_IN = (D / 64) * NB_IN, I_O = (D / 64) * (D / 64), I_1 = (D / 64) * (FF / 64), I_2 = (FF / 64) * (D / 64);
        constexpr int NITEMS = I_IN + I_O + I_1 + I_2;
        bf16* WinT = (bf16*)(ws + WS_WIN); bf16* WoT = (bf16*)(ws + WS_WO); bf16* W1T = (bf16*)(ws + WS_W1); bf16* W2T = (bf16*)(ws + WS_W2);
        unsigned* qh = (unsigned*)(ws + WS_CTL) + CW_Q + 64 * F.wave;
        unsigned qraw = 0; if (F.lane == 0) qraw = __hip_atomic_fetch_add(qh, 1u, __ATOMIC_RELAXED, __HIP_MEMORY_SCOPE_AGENT);
        for (;;) {
            const int it = (int)__builtin_amdgcn_readfirstlane(qraw) * NWAVES + F.wave; if (it >= NITEMS - N_DEFER) break;
            if (F.lane == 0) qraw = __hip_atomic_fetch_add(qh, 1u, __ATOMIC_RELAXED, __HIP_MEMORY_SCOPE_AGENT);
            int r = it;
            if (r < I_IN) { const int kb = r / NB_IN, nb = r % NB_IN;
                if (nb < 96) p0_transpose_item(p.in[I_WIN], D, IN_COLS, WinT, 64 * kb, 64 * nb, 64 * nb, scr, F.lane);
                else if (nb < 160) p0_transpose_item(p.in[I_WIN], D, IN_COLS, WinT, 64 * kb, C_SG + 64 * (nb - 96), C_LF + 64 * (nb - 96), scr, F.lane);
                else {
                    const float* W = p.in[I_WIN]; const int k0 = 64 * kb;
#pragma unroll 8
                    for (int i = 0; i < 32; ++i) { const int kk = 2 * i + (F.lane >> 5); scr[kk * 65 + (F.lane & 31)] = W[(size_t)(k0 + kk) * IN_COLS + C_LF + (F.lane & 31)]; }
                    LDS_WAIT(); asm volatile("" ::: "memory");
                    const int c = F.lane & 7;
#pragma unroll
                    for (int j = 0; j < 4; ++j) { const int n = (F.lane >> 3) + 8 * j; const LAS float* s2 = scr + (8 * c) * 65 + n;
                        v4u o; o.x = pk2(s2[0 * 65], s2[1 * 65]); o.y = pk2(s2[2 * 65], s2[3 * 65]); o.z = pk2(s2[4 * 65], s2[5 * 65]); o.w = pk2(s2[6 * 65], s2[7 * 65]);
                        *(v4u*)(WinT + (size_t)(IN_COLS - 32 + n) * D + k0 + 8 * c) = o; }
                    LDS_WAIT(); asm volatile("" ::: "memory");
                }
                continue; } r -= I_IN;
            if (r < I_O) { const int nbk = D / 64, kb = r / nbk, nb = r % nbk; p0_transpose_item(p.in[I_WO], D, D, WoT, 64 * kb, 64 * nb, 64 * nb, scr, F.lane); continue; } r -= I_O;
            if (r < I_1) { const int nbk = FF / 64, kb = r / nbk, nb = r % nbk; p0_transpose_item(p.in[I_W1], D, FF, W1T, 64 * kb, 64 * nb, 64 * nb, scr, F.lane); continue; } r -= I_1;
            { const int nbk = D / 64, kb = r / nbk, nb = r % nbk; p0_transpose_item(p.in[I_W2], FF, D, W2T, 64 * kb, 64 * nb, 64 * nb, scr, F.lane); }
        }
    }
}

__device__ __forceinline__ void p3x_deferred(LAS unsigned char* lds_, const Params& p) {
    const Frame F = mk_frame(lds_);
    LAS float* scr = (LAS float*)(F.lds + F.wave * 16896);
    bf16* W2T = (bf16*)(p.ws + WS_W2);
    unsigned* qh = (unsigned*)(p.ws + WS_CTL) + CW_Q2 + 64 * F.wave;
    unsigned qraw = 0; if (F.lane == 0) qraw = __hip_atomic_fetch_add(qh, 1u, __ATOMIC_RELAXED, __HIP_MEMORY_SCOPE_AGENT);
    for (;;) {
        const int it = (int)__builtin_amdgcn_readfirstlane(qraw) * NWAVES + F.wave; if (it >= N_DEFER) break;
        if (F.lane == 0) qraw = __hip_atomic_fetch_add(qh, 1u, __ATOMIC_RELAXED, __HIP_MEMORY_SCOPE_AGENT);
        const int r = (FF / 64) * (D / 64) - N_DEFER + it, nbk = D / 64, kb = r / nbk, nb = r % nbk;
        p0_transpose_item(p.in[I_W2], FF, D, W2T, 64 * kb, 64 * nb, 64 * nb, scr, F.lane);
    }
    __syncthreads();
}

__device__ __forceinline__ void p1_rows(LAS unsigned char* lds_, const Params& p) {
    const Frame F = mk_frame(lds_);
    LAS float* cA = (LAS float*)F.lds; LAS float* cB = cA + D;
    const float* mod = (const float*)(p.ws + WS_MOD); bf16* A1 = (bf16*)(p.ws + WS_A1);
    const int per = (MT + F.G - 1) / F.G; int r0 = F.bid * per; const int rend = (r0 + per < MT) ? r0 + per : MT;
    while (r0 < rend) {
        const int bb = r0 < M ? r0 / SEQ : 4; const int bend = r0 < M ? (bb + 1) * SEQ : MT; const int r1 = rend < bend ? rend : bend;
        __syncthreads();
        { float g_[8], sc_[8], sh_[8];
#pragma unroll
          for (int j = 0; j < 8; ++j) { const int c = F.tid + NTHR * j; g_[j] = p.in[I_PRE1][c]; sc_[j] = mod[(size_t)bb * NMOD * D + D + c]; sh_[j] = mod[(size_t)bb * NMOD * D + c]; }
#pragma unroll
          for (int j = 0; j < 8; ++j) { const int c = F.tid + NTHR * j; cA[c] = g_[j] * (1.0f + sc_[j]); cB[c] = sh_[j]; } }
        __syncthreads();
        f32x4 v[16], vn[16];
#define P1_LD(Vv, r_) do { const float* xr_ = (r_) < M ? p.in[I_X] + (size_t)(r_) * D : p.in[I_CTX] + (size_t)((r_) - M) * D; \
            _Pragma("unroll") for (int j = 0; j < 16; ++j) Vv[j] = __builtin_nontemporal_load((const f32x4*)(xr_ + 256 * j + 4 * F.lane)); } while (0)
        if (r0 + F.wave < r1) P1_LD(vn, r0 + F.wave);
        for (int r = r0 + F.wave; r < r1; r += NWAVES) {
#pragma unroll
            for (int j = 0; j < 16; ++j) v[j] = vn[j];
            if (r + NWAVES < r1) P1_LD(vn, r + NWAVES);
            float ss = 0.f;
#pragma unroll
            for (int j = 0; j < 16; ++j) ss += (v[j][0] * v[j][0] + v[j][1] * v[j][1]) + (v[j][2] * v[j][2] + v[j][3] * v[j][3]);
            const float rstd = rsqrtf(wave_sum(ss) * (1.0f / D) + EPS);
            bf16* orow = A1 + (size_t)r * D;
#pragma unroll
            for (int j = 0; j < 16; ++j) { const f32x4 a = *(LAS f32x4*)(cA + 256 * j + 4 * F.lane), b = *(LAS f32x4*)(cB + 256 * j + 4 * F.lane); const f32x4 o = v[j] * rstd * a + b;
                v2u w; w.x = pk2(o[0], o[1]); w.y = pk2(o[2], o[3]); st_global_b64(orow + 256 * j + 4 * F.lane, w); }
        }
#undef P1_LD
        r0 = r1;
    }
    __syncthreads();
}

__device__ __forceinline__ bf16x8 ldfrag(const LAS unsigned char* base, int row, int stride, int kbyte) { return *(const LAS bf16x8*)(base + row * stride + kbyte); }
__device__ __forceinline__ void p3_sg(LAS unsigned char* lds_, const Params& p) {
    const Frame F = mk_frame(lds_);
    constexpr int WS_OFF = 0, VN_OFF = 34816, ST_OFF = 69632, STR = 272;
    const bf16* VV = (const bf16*)(p.ws + WS_VV); const bf16* U = (const bf16*)(p.ws + WS_U); bf16* Y = (bf16*)(p.ws + WS_Y); const float* sgstat = (const float*)(p.ws + WS_SGSTAT);
    const int l15 = F.lane & 15, lq = F.lane >> 4;
    constexpr int NUNITS = SGG * BATCH * (SEQ / SGC) * 4;
    int u0, u1; { const int nt = (F.G > pg8::N_TAIL) ? pg8::N_TAIL : 0, nf = F.G - nt; int lo = (NUNITS - 21 * nf) / F.G; if (lo < 0 || nt == 0) lo = 0; int hi = nf > 0 ? (NUNITS - lo * nt + nf - 1) / nf : 0;
        if (nt == 0) { hi = (NUNITS + F.G - 1) / F.G; }
        if (F.bid >= nt) { u0 = (F.bid - nt) * hi; u1 = u0 + hi; } else { u0 = nf * hi + F.bid * lo; u1 = u0 + lo; }
        if (u0 > NUNITS) u0 = NUNITS; if (u1 > NUNITS) u1 = NUNITS;
        if (nt > 0 && F.bid == nt - 1) u1 = NUNITS; }
    int gcur = -1;
    bf16x8 Iev, Iod; { const int ie = l15 - 8 * lq, io = 16 + l15 - 8 * lq; unsigned iev[4] = {0u, 0u, 0u, 0u}, iod[4] = {0u, 0u, 0u, 0u};
#pragma unroll
        for (int e = 0; e < 8; ++e) { if (ie == e) iev[e >> 1] = (e & 1) ? 0x3F800000u : 0x00003F80u; if (io == e) iod[e >> 1] = (e & 1) ? 0x3F800000u : 0x00003F80u; }
        Iev = __builtin_bit_cast(bf16x8, (v4u){iev[0], iev[1], iev[2], iev[3]}); Iod = __builtin_bit_cast(bf16x8, (v4u){iod[0], iod[1], iod[2], iod[3]}); }
    struct SgRegs { v4u av[4]; f32x4 st[4]; v2u uu[8]; float lg[8], lb[8]; };
#define SG_DECODE(un_) const int g_ = (un_) / 512, rem_ = (un_) % 512, b_ = rem_ / 128, n_ = (rem_ % 128) / 4, cs_ = rem_ % 4; const int row0_ = b_ * SEQ + n_ * SGC, ch0_ = g_ * SGGW + cs_ * 128;
#define SG_LOAD(R, un_) do { SG_DECODE(un_) \
        _Pragma("unroll") for (int ks = 0; ks < 4; ++ks) R.av[ks] = *(const v4u*)(VV + (size_t)(row0_ + 16 * F.wave + l15) * SGW + ch0_ + 32 * ks + 8 * lq); \
        _Pragma("unroll") for (int k = 0; k < 4; ++k) R.st[k] = *(const f32x4*)(sgstat + (size_t)(row0_ + (F.tid >> 2)) * 64 + (F.tid & 3) * 16 + 4 * k); \
        _Pragma("unroll") for (int ti = 0; ti < 8; ++ti) R.uu[ti] = *(const v2u*)(U + (size_t)(row0_ + 16 * ti + l15) * SGW + ch0_ + 16 * F.wave + 4 * lq); \
        _Pragma("unroll") for (int ks = 0; ks < 4; ++ks) { R.lg[2 * ks] = p.in[I_SGLG][ch0_ + 32 * ks + l15]; R.lb[2 * ks] = p.in[I_SGLB][ch0_ + 32 * ks + l15]; R.lg[2 * ks + 1] = p.in[I_SGLG][ch0_ + 32 * ks + 16 + l15]; R.lb[2 * ks + 1] = p.in[I_SGLB][ch0_ + 32 * ks + 16 + l15]; } } while (0)
#ifdef PROBE_PAIR
    unsigned long long sgt_[7] = {0, 0, 0, 0, 0, 0, 0}, sgl_ = 0; const bool sgp_ = (blockIdx.x == gridDim.x - 1 && threadIdx.x == 0);
#define SGT(k) do { if (sgp_) { const unsigned long long n_ = __builtin_amdgcn_s_memrealtime(); if ((k) > 0) sgt_[k] += n_ - sgl_; sgl_ = n_; } } while (0)
#else
#define SGT(k) do { } while (0)
#endif
    SgRegs R, Rn; float bsv[8] = {0.f, 0.f, 0.f, 0.f, 0.f, 0.f, 0.f, 0.f};
    if (u0 < u1) SG_LOAD(Rn, u0);
    for (int un = u0; un < u1; ++un) {
        SG_DECODE(un) const int g = g_, row0 = row0_, ch0 = ch0_;
        R = Rn;
        if (un + 1 < u1) SG_LOAD(Rn, un + 1);
        SGT(0);
        LDS_BARRIER();
        SGT(1);
        if (g != gcur) { gcur = g; const float* W = p.in[I_WS] + (size_t)g * SGC * SGC;
#pragma unroll
            for (int ti = 0; ti < 8; ++ti) bsv[ti] = p.in[I_BS][g * SGC + 16 * ti + l15];
            for (int i = F.tid; i < SGC * SGC / 4; i += NTHR) { const int r = i / 32, c4 = (i % 32) * 4; const f32x4 w = *(const f32x4*)(W + r * SGC + c4);
                v2u o; o.x = pk2(w[0], w[1]); o.y = pk2(w[2], w[3]); *(LAS v2u*)(F.lds + WS_OFF + r * STR + c4 * 2) = o; } }
        { const int row = F.tid >> 2, part = F.tid & 3; float s1 = 0.f, s2 = 0.f;
#pragma unroll
          for (int k = 0; k < 4; ++k) { s1 += R.st[k][0] + R.st[k][2]; s2 += R.st[k][1] + R.st[k][3]; }
          s1 += __shfl_xor(s1, 1); s2 += __shfl_xor(s2, 1); s1 += __shfl_xor(s1, 2); s2 += __shfl_xor(s2, 2);
          if (part == 0) { const float mu = s1 * (1.0f / SGW), var = s2 * (1.0f / SGW) - mu * mu; *(LAS f32x2*)(F.lds + ST_OFF + row * 8) = (f32x2){mu, rsqrtf(var + EPS)}; } }
        SGT(2);
        LDS_BARRIER();
        SGT(3);
        { const int tm = F.wave; const f32x4 stA = *(const LAS f32x4*)(F.lds + ST_OFF + (16 * tm + 4 * lq) * 8), stB = *(const LAS f32x4*)(F.lds + ST_OFF + (16 * tm + 4 * lq + 2) * 8);
          const float mu[4] = {stA[0], stA[2], stB[0], stB[2]}, rs[4] = {stA[1], stA[3], stB[1], stB[3]};
#pragma unroll
          for (int ks = 0; ks < 4; ++ks) { const f32x4 z = (f32x4){0.f, 0.f, 0.f, 0.f}; const bf16x8 a = __builtin_bit_cast(bf16x8, R.av[ks]);
              const f32x4 d0 = __builtin_amdgcn_mfma_f32_16x16x32_bf16(a, Iev, z, 0, 0, 0), d1 = __builtin_amdgcn_mfma_f32_16x16x32_bf16(a, Iod, z, 0, 0, 0);
              const int ca = 32 * ks + l15, cb = ca + 16; const float ga = R.lg[2 * ks], ba = R.lb[2 * ks], gb = R.lg[2 * ks + 1], bb = R.lb[2 * ks + 1];
              float ya[4], yb[4];
#pragma unroll
              for (int r = 0; r < 4; ++r) { ya[r] = (d0[r] - mu[r]) * rs[r] * ga + ba; yb[r] = (d1[r] - mu[r]) * rs[r] * gb + bb; }
              *(LAS v2u*)(F.lds + VN_OFF + ca * STR + (16 * tm + 4 * lq) * 2) = (v2u){pk2(ya[0], ya[1]), pk2(ya[2], ya[3])};
              *(LAS v2u*)(F.lds + VN_OFF + cb * STR + (16 * tm + 4 * lq) * 2) = (v2u){pk2(yb[0], yb[1]), pk2(yb[2], yb[3])}; } }
        SGT(4);
        LDS_BARRIER();
        SGT(5);
        f32x4 acc[8];
#pragma unroll
        for (int ti = 0; ti < 8; ++ti) acc[ti] = (f32x4){0.f, 0.f, 0.f, 0.f};
#pragma unroll
        for (int ks = 0; ks < 4; ++ks) { const bf16x8 a = ldfrag(F.lds + VN_OFF, 16 * F.wave + l15, STR, (8 * lq + 32 * ks) * 2);
#pragma unroll
            for (int ti = 0; ti < 8; ++ti) { const bf16x8 bb = ldfrag(F.lds + WS_OFF, 16 * ti + l15, STR, (8 * lq + 32 * ks) * 2); acc[ti] = __builtin_amdgcn_mfma_f32_16x16x32_bf16(a, bb, acc[ti], 0, 0, 0); } }
#pragma unroll
        for (int ti = 0; ti < 8; ++ti) { const int i = 16 * ti + l15, c = 16 * F.wave + 4 * lq; const float bs = bsv[ti];
            const v2u uu = R.uu[ti];
            const float o0 = bf_lo(uu.x) * (acc[ti][0] + bs), o1 = bf_hi(uu.x) * (acc[ti][1] + bs), o2 = bf_lo(uu.y) * (acc[ti][2] + bs), o3 = bf_hi(uu.y) * (acc[ti][3] + bs);
            v2u w; w.x = pk2(o0, o1); w.y = pk2(o2, o3); st_global_b64(Y + (size_t)(row0 + i) * D + VALW + ch0 + c, w); }
        SGT(6);
    }
#undef SG_LOAD
#undef SG_DECODE
#ifdef PROBE_PAIR
    if (sgp_) { unsigned long long* o_ = (unsigned long long*)(p.ws + WS_CTL + 32768) + 48; for (int k_ = 0; k_ < 7; ++k_) o_[k_] = sgt_[k_]; }
#endif
#undef SGT
    __syncthreads();
}


constexpr int BL_QT = 0, BL_KH = 17408, BL_ATT = 35840, BL_EBL = 45056, BLOB = 46080, VTIMG = 36864, NCH = 68;
constexpr size_t WS_BLOB = WS_MIX;
constexpr size_t WS_VT = WS_BLOB + (size_t)BATCH * HEADS * 2 * NCH * BLOB;
constexpr size_t WS_END2 = WS_VT + (size_t)BATCH * HEADS * NCH * VTIMG;
__device__ __forceinline__ float dpp_swap1(float x) { return __builtin_bit_cast(float, __builtin_amdgcn_update_dpp(0, __builtin_bit_cast(int, x), 0xB1, 0xF, 0xF, true)); }
__device__ __forceinline__ float logsig16(float a) { return (fminf(a, 0.f) - __logf(1.0f + __expf(-fabsf(a)))) * (1.0f / 16.0f); }
__device__ __forceinline__ void p3_gla_pre(LAS unsigned char* lds_, const Params& p) {
    const Frame F = mk_frame(lds_);
    constexpr int KT = 46080, GT = 63488, VTI = 65536;
    constexpr int S128 = 272, S64 = 144;
    const bf16* Qg = (const bf16*)(p.ws + WS_Q); const bf16* Kg = (const bf16*)(p.ws + WS_KB); const bf16* Vg = (const bf16*)(p.ws + WS_V); const float* LRg = (const float*)(p.ws + WS_LR);
    const float* tab = (const float*)(p.ws + WS_ROPE);
    const int w = F.wave, lane = F.lane, l15 = lane & 15, lq = lane >> 4, tt = w & 3, chh = w >> 2;
    float csC[2][4], snC[2][4];
#pragma unroll
    for (int pp = 0; pp < 2; ++pp)
#pragma unroll
        for (int r = 0; r < 4; ++r) { const f32x2 t = *(const f32x2*)(tab + ((16 * tt + 4 * lq + r) * 32 + 16 * pp + l15) * 2); csC[pp][r] = t.x; snC[pp][r] = t.y; }
    bf16x8 Iev, Iod; { const int ie = l15 - 8 * lq, io = 16 + l15 - 8 * lq; unsigned iev[4] = {0u, 0u, 0u, 0u}, iod[4] = {0u, 0u, 0u, 0u};
#pragma unroll
        for (int e = 0; e < 8; ++e) { if (ie == e) iev[e >> 1] = (e & 1) ? 0x3F800000u : 0x00003F80u; if (io == e) iod[e >> 1] = (e & 1) ? 0x3F800000u : 0x00003F80u; }
        Iev = __builtin_bit_cast(bf16x8, (v4u){iev[0], iev[1], iev[2], iev[3]}); Iod = __builtin_bit_cast(bf16x8, (v4u){iod[0], iod[1], iod[2], iod[3]}); }
    constexpr int NLAT = BATCH * HEADS * 64, NCTX = BATCH * HEADS * 4;
    const int per = (NLAT + F.G - 1) / F.G;
    const int n_lat = (F.bid * per >= NLAT) ? 0 : ((NLAT - F.bid * per) < per ? (NLAT - F.bid * per) : per);
    const int n_ctx = F.bid < NCTX ? (NCTX - F.bid + F.G - 1) / F.G : 0, total = n_lat + n_ctx;
    struct PreRegs { v4u q[2], k[2]; f32x4 lr[4]; f32x2 rt[2]; };
#define PRE_DECODE(i_) int b_, h_, cidx_; if ((i_) < n_lat) { const int un_ = F.bid * per + (i_); b_ = un_ >> 9; h_ = (un_ >> 6) & 7; cidx_ = 4 + (un_ & 63); } else { const int un_ = F.bid + ((i_) - n_lat) * F.G; b_ = un_ >> 5; h_ = (un_ >> 2) & 7; cidx_ = un_ & 3; } \
        const bool ctx_ = cidx_ < 4; const size_t row0_ = ctx_ ? (size_t)(M + b_ * CTXL + cidx_ * 64) : (size_t)(b_ * SEQ + (cidx_ - 4) * 64);
#define PRE_LOAD(R, i_) do { PRE_DECODE(i_) const size_t rt_ = row0_ + 16 * tt + l15; \
        _Pragma("unroll") for (int ksl = 0; ksl < 2; ++ksl) { if (!ctx_) R.q[ksl] = *(const v4u*)(Qg + rt_ * KEYW + h_ * DK + 64 * chh + 32 * ksl + 8 * lq); R.k[ksl] = *(const v4u*)(Kg + rt_ * KEYW + h_ * DK + 64 * chh + 32 * ksl + 8 * lq); } \
        _Pragma("unroll") for (int pp_ = 0; pp_ < 2; ++pp_) R.rt[pp_] = *(const f32x2*)(tab + ((ctx_ ? 0 : cidx_ - 4) * 32 + 16 * pp_ + l15) * 2); \
        _Pragma("unroll") for (int d = 0; d < 2; ++d) { R.lr[2 * d] = *(const f32x4*)(LRg + rt_ * 32 + d * 16 + 8 * (lq & 1)); R.lr[2 * d + 1] = *(const f32x4*)(LRg + rt_ * 32 + d * 16 + 8 * (lq & 1) + 4); } } while (0)
    PreRegs R, Rn;
    if (total > 0) PRE_LOAD(Rn, 0);
    bf16x8 wdf[2][4]; float bias[2][4]; int hcur = -1;
#pragma unroll
    for (int d = 0; d < 2; ++d)
#pragma unroll
        for (int tq = 0; tq < 4; ++tq) { wdf[d][tq] = Iev; bias[d][tq] = 0.f; }
    for (int it = 0; it < total; ++it) {
        PRE_DECODE(it) const int b = b_, h = h_, cidx = cidx_; const bool ctx = ctx_; const int ch = ctx ? cidx : cidx - 4;
        R = Rn;
        if (it + 1 < total) PRE_LOAD(Rn, it + 1);
        if (h != hcur) { hcur = h;
#pragma unroll
            for (int d = 0; d < 2; ++d) { const float* wd = p.in[d ? I_WDB : I_WDF]; const float* bd = p.in[d ? I_BDB : I_BDF];
#pragma unroll
                for (int tq = 0; tq < 4; ++tq) { const int c = h * DK + 64 * chh + 16 * tq + l15; unsigned pk[4];
#pragma unroll
                    for (int e = 0; e < 8; e += 2) pk[e >> 1] = pk2(wd[(8 * (lq & 1) + e) * KEYW + c], wd[(8 * (lq & 1) + e + 1) * KEYW + c]);
                    wdf[d][tq] = __builtin_bit_cast(bf16x8, (v4u){pk[0], pk[1], pk[2], pk[3]}); bias[d][tq] = bd[c]; } } }
        LDS_BARRIER();
        const f32x4 z4 = (f32x4){0.f, 0.f, 0.f, 0.f};
        float qv[4][4], kv[4][4];
#pragma unroll
        for (int ksl = 0; ksl < 2; ++ksl) { const bf16x8 ak = __builtin_bit_cast(bf16x8, R.k[ksl]);
            const f32x4 k0 = __builtin_amdgcn_mfma_f32_16x16x32_bf16(ak, Iev, z4, 0, 0, 0), k1 = __builtin_amdgcn_mfma_f32_16x16x32_bf16(ak, Iod, z4, 0, 0, 0);
            f32x4 q0 = z4, q1 = z4; if (!ctx) { const bf16x8 aq = __builtin_bit_cast(bf16x8, R.q[ksl]); q0 = __builtin_amdgcn_mfma_f32_16x16x32_bf16(aq, Iev, z4, 0, 0, 0); q1 = __builtin_amdgcn_mfma_f32_16x16x32_bf16(aq, Iod, z4, 0, 0, 0); }
#pragma unroll
            for (int r = 0; r < 4; ++r) { kv[2 * ksl][r] = k0[r]; kv[2 * ksl + 1][r] = k1[r]; qv[2 * ksl][r] = q0[r]; qv[2 * ksl + 1][r] = q1[r]; } }
        if (!ctx) {
#pragma unroll
            for (int pp = 0; pp < 2; ++pp) { const float c0 = R.rt[pp].x, s0 = R.rt[pp].y;
#pragma unroll
                for (int r = 0; r < 4; ++r) { const float cc = chh ? csC[pp][r] : c0, ss = chh ? snC[pp][r] : s0;
                    const float qa = qv[pp][r] * cc - qv[pp + 2][r] * ss, qb = qv[pp][r] * ss + qv[pp + 2][r] * cc; qv[pp][r] = qa; qv[pp + 2][r] = qb;
                    const float ka = kv[pp][r] * cc - kv[pp + 2][r] * ss, kb = kv[pp][r] * ss + kv[pp + 2][r] * cc; kv[pp][r] = ka; kv[pp + 2][r] = kb; } }
        }
#pragma unroll
        for (int dir = 0; dir < 2; ++dir) {
            bf16x8 afr; { const f32x4 l0 = R.lr[2 * dir], l1 = R.lr[2 * dir + 1];
                float x[8] = {l0[0], l0[1], l0[2], l0[3], l1[0], l1[1], l1[2], l1[3]}; unsigned pk[4];
#pragma unroll
                for (int e = 0; e < 8; e += 2) { float a0 = x[e], a1 = x[e + 1]; if (lq >= 2) { a0 -= bf_lo(pk2(a0, 0.f)); a1 -= bf_lo(pk2(a1, 0.f)); } pk[e >> 1] = pk2(a0, a1); }
                afr = __builtin_bit_cast(bf16x8, (v4u){pk[0], pk[1], pk[2], pk[3]}); }
            float cu[4][4];
#pragma unroll
            for (int tq = 0; tq < 4; ++tq) { const float bs = bias[dir][tq]; f32x4 a4 = (f32x4){bs, bs, bs, bs};
                a4 = __builtin_amdgcn_mfma_f32_16x16x32_bf16(afr, wdf[dir][tq], a4, 0, 0, 0);
#pragma unroll
                for (int r = 0; r < 4; ++r) cu[tq][r] = logsig16(a4[r]); }
#pragma unroll
            for (int tq = 0; tq < 4; ++tq) {
                if (!dir) { cu[tq][1] += cu[tq][0]; cu[tq][2] += cu[tq][1]; cu[tq][3] += cu[tq][2]; } else { cu[tq][2] += cu[tq][3]; cu[tq][1] += cu[tq][2]; cu[tq][0] += cu[tq][1]; }
                const float tl = dir ? cu[tq][0] : cu[tq][3]; float inc = tl;
                if (!dir) { float t = __shfl_up(inc, 16); if (lq >= 1) inc += t; t = __shfl_up(inc, 32); if (lq >= 2) inc += t; }
                else      { float t = __shfl_down(inc, 16); if (lq <= 2) inc += t; t = __shfl_down(inc, 32); if (lq <= 1) inc += t; }
                const float ex = inc - tl;
#pragma unroll
                for (int r = 0; r < 4; ++r) cu[tq][r] += ex;
                if (lq == (dir ? 0 : 3)) ((LAS float*)(F.lds + GT))[tt * DK + 64 * chh + 16 * tq + l15] = inc;
            }
            LDS_BARRIER();
#pragma unroll
            for (int tq = 0; tq < 4; ++tq) { const int c = 64 * chh + 16 * tq + l15; float off = 0.f, tot = 0.f;
#pragma unroll
                for (int t2 = 0; t2 < 4; ++t2) { const float g = ((const LAS float*)(F.lds + GT))[t2 * DK + c]; tot += g; if (dir ? (t2 > tt) : (t2 < tt)) off += g; }
                const float et = __expf(tot); if (tt == 0 && lq == 0) ((LAS float*)(F.lds + BL_EBL))[c] = et;
                float kh[4], qs[4], ks4[4];
#pragma unroll
                for (int r = 0; r < 4; ++r) { const float bq = cu[tq][r] + off, eb = __expf(bq), ei = __builtin_amdgcn_rcpf(eb);
                    const float kt = kv[tq][r] * ei; kh[r] = kt * et; ks4[r] = kt; qs[r] = qv[tq][r] * eb; }
                if (!ctx) {
                    const bool odd = l15 & 1; const int i0 = 16 * tt + 4 * lq + (odd ? 2 : 0), cd = (c & ~1) * 2;
                    const float q0 = dpp_swap1(odd ? qs[0] : qs[2]), q1 = dpp_swap1(odd ? qs[1] : qs[3]), k0 = dpp_swap1(odd ? ks4[0] : ks4[2]), k1 = dpp_swap1(odd ? ks4[1] : ks4[3]);
                    *(LAS unsigned*)(F.lds + BL_QT + i0 * S128 + cd) = odd ? pk2(q0, qs[2]) : pk2(qs[0], q0); *(LAS unsigned*)(F.lds + BL_QT + (i0 + 1) * S128 + cd) = odd ? pk2(q1, qs[3]) : pk2(qs[1], q1);
                    *(LAS unsigned*)(F.lds + KT + i0 * S128 + cd) = odd ? pk2(k0, ks4[2]) : pk2(ks4[0], k0); *(LAS unsigned*)(F.lds + KT + (i0 + 1) * S128 + cd) = odd ? pk2(k1, ks4[3]) : pk2(ks4[1], k1); }
                *(LAS v2u*)(F.lds + BL_KH + c * S64 + (16 * tt + 4 * lq) * 2) = (v2u){pk2(kh[0], kh[1]), pk2(kh[2], kh[3])}; }
            LDS_BARRIER();
            if (!ctx) {
                const int ti = w & 3;
#pragma unroll
                for (int t2 = 0; t2 < 2; ++t2) { const int tj = 2 * (w >> 2) + t2; f32x4 a4 = (f32x4){0.f, 0.f, 0.f, 0.f};
#pragma unroll
                    for (int ks = 0; ks < 4; ++ks) a4 = __builtin_amdgcn_mfma_f32_16x16x32_bf16(ldfrag(F.lds + KT, 16 * tj + l15, S128, (8 * lq + 32 * ks) * 2), ldfrag(F.lds + BL_QT, 16 * ti + l15, S128, (8 * lq + 32 * ks) * 2), a4, 0, 0, 0);
                    const int i = 16 * ti + l15, j0 = 16 * tj + 4 * lq; float m[4];
#pragma unroll
                    for (int r = 0; r < 4; ++r) { const int j = j0 + r; const bool keep = dir ? (j >= i) : (j <= i); m[r] = keep ? a4[r] : 0.f; }
                    *(LAS v2u*)(F.lds + BL_ATT + i * S64 + j0 * 2) = (v2u){pk2(m[0], m[1]), pk2(m[2], m[3])}; }
                LDS_BARRIER();
            }
            { unsigned char* bg = p.ws + WS_BLOB + ((size_t)((b * HEADS + h) * 2 + dir) * NCH + cidx) * BLOB;
              for (int i = F.tid; i < BLOB / 16; i += NTHR) st_global_b128(bg + i * 16, *(const LAS v4u*)(F.lds + i * 16));
            }
        }
    }
#undef PRE_LOAD
#undef PRE_DECODE
    __syncthreads();
}

__device__ __forceinline__ void p3_gla_scan(LAS unsigned char* lds_, const Params& p) {
    const Frame F = mk_frame(lds_);
    constexpr int BUFB = BLOB + 9216, ST0 = 2 * BUFB, STB = 17408, S128 = 272, S64 = 144;
    constexpr int NPIECE = BUFB / 1024;
    const int w = F.wave, lane = F.lane, l15 = lane & 15, lq = lane >> 4;
    const bf16* Vg = (const bf16*)(p.ws + WS_V);
    bf16x8 Iev, Iod; { const int ie = l15 - 8 * lq, io = 16 + l15 - 8 * lq; unsigned iev[4] = {0u, 0u, 0u, 0u}, iod[4] = {0u, 0u, 0u, 0u};
#pragma unroll
        for (int e = 0; e < 8; ++e) { if (ie == e) iev[e >> 1] = (e & 1) ? 0x3F800000u : 0x00003F80u; if (io == e) iod[e >> 1] = (e & 1) ? 0x3F800000u : 0x00003F80u; }
        Iev = __builtin_bit_cast(bf16x8, (v4u){iev[0], iev[1], iev[2], iev[3]}); Iod = __builtin_bit_cast(bf16x8, (v4u){iod[0], iod[1], iod[2], iod[3]}); }
    for (int un = F.bid; un < 256; un += F.G) {
        const int xcd = un & 7, slot = un >> 3, chain = xcd * 8 + (slot >> 2), dvs = slot & 3;
        const int b = chain >> 4, h = (chain >> 1) & 7, dir = chain & 1;
        bf16* Og = (bf16*)(p.ws + (dir ? WS_OB : WS_OF));
        const unsigned char* blobs = p.ws + WS_BLOB + (size_t)((b * HEADS + h) * 2 + dir) * NCH * BLOB;
        __syncthreads();
        for (int i = F.tid; i < STB / 4; i += NTHR) ((LAS unsigned*)(F.lds + ST0))[i] = 0u;
        f32x4 S[4];
#pragma unroll
        for (int tv = 0; tv < 4; ++tv) S[tv] = (f32x4){0.f, 0.f, 0.f, 0.f};
#define SCAN_CIDX(s) ((s) < 4 ? (dir ? 3 - (s) : (s)) : (dir ? 71 - (s) : (s)))
#define SCAN_ROW0(ci_) ((ci_) < 4 ? (size_t)(M + b * CTXL + (ci_) * 64) : (size_t)(b * SEQ + ((ci_) - 4) * 64))
#define SCAN_LD(R, s) do { const int ci_ = SCAN_CIDX(s); const unsigned char* bg_ = blobs + (size_t)ci_ * BLOB; \
            _Pragma("unroll") for (int j_ = 0; j_ < 6; ++j_) { const int q_ = F.tid + NTHR * j_; if (j_ < 5 || F.tid < 320) R[j_] = *(const v4u*)(bg_ + q_ * 16); } \
            R[6] = *(const v4u*)(Vg + (SCAN_ROW0(ci_) + 16 * (w & 3) + l15) * VALW + h * DV + dvs * 64 + 32 * (w >> 2) + 8 * lq); } while (0)
#define SCAN_ST(R, s) do { const int bo_ = ((s) & 1) * BUFB; \
            _Pragma("unroll") for (int j_ = 0; j_ < 6; ++j_) { const int q_ = F.tid + NTHR * j_; if (j_ < 5 || F.tid < 320) *(LAS v4u*)(F.lds + bo_ + q_ * 16) = R[j_]; } \
            { const bf16x8 a_ = __builtin_bit_cast(bf16x8, R[6]); const f32x4 z_ = (f32x4){0.f, 0.f, 0.f, 0.f}; \
              const f32x4 d0_ = __builtin_amdgcn_mfma_f32_16x16x32_bf16(a_, Iev, z_, 0, 0, 0), d1_ = __builtin_amdgcn_mfma_f32_16x16x32_bf16(a_, Iod, z_, 0, 0, 0); \
              LAS unsigned char* vt_ = F.lds + bo_ + BLOB + (32 * (w >> 2) + l15) * S64 + (16 * (w & 3) + 4 * lq) * 2; \
              *(LAS v2u*)vt_ = (v2u){pk2(d0_[0], d0_[1]), pk2(d0_[2], d0_[3])}; *(LAS v2u*)(vt_ + 16 * S64) = (v2u){pk2(d1_[0], d1_[1]), pk2(d1_[2], d1_[3])}; } } while (0)
        v4u RA[7], RB[7];
        SCAN_LD(RA, 0); SCAN_LD(RB, 1);
        SCAN_ST(RA, 0); SCAN_LD(RA, 2);
#pragma unroll 1
        for (int s2 = 0; s2 < NCH; s2 += 2) {
#pragma unroll
          for (int par = 0; par < 2; ++par) { const int s = s2 + par;
            const bool ctx = s < 4; const int ci = SCAN_CIDX(s); const int ch = ci - 4;
            const LAS unsigned char* buf = F.lds + (s & 1) * BUFB; const LAS unsigned char* vt = buf + BLOB;
            const LAS unsigned char* stc = F.lds + ST0 + (s & 1) * STB; LAS unsigned char* stn = F.lds + ST0 + ((s + 1) & 1) * STB;
            LDS_BARRIER();
            if (s + 1 < NCH) { if (par == 0) SCAN_ST(RB, s + 1); else SCAN_ST(RA, s + 1); }
            if (s + 3 < NCH) { if (par == 0) SCAN_LD(RB, s + 3); else SCAN_LD(RA, s + 3); }
            if (!ctx) {
                const int ti = w & 3; const size_t row0 = (size_t)(b * SEQ + ch * 64);
#pragma unroll
                for (int t2 = 0; t2 < 2; ++t2) { const int tv = 2 * (w >> 2) + t2; f32x4 o4 = (f32x4){0.f, 0.f, 0.f, 0.f};
#pragma unroll
                    for (int ks = 0; ks < 4; ++ks) o4 = __builtin_amdgcn_mfma_f32_16x16x32_bf16(ldfrag(stc, 16 * tv + l15, S128, (8 * lq + 32 * ks) * 2), ldfrag(buf + BL_QT, 16 * ti + l15, S128, (8 * lq + 32 * ks) * 2), o4, 0, 0, 0);
#pragma unroll
                    for (int ks = 0; ks < 2; ++ks) o4 = __builtin_amdgcn_mfma_f32_16x16x32_bf16(ldfrag(vt, 16 * tv + l15, S64, (8 * lq + 32 * ks) * 2), ldfrag(buf + BL_ATT, 16 * ti + l15, S64, (8 * lq + 32 * ks) * 2), o4, 0, 0, 0);
                    const int i = 16 * ti + l15, v0 = 16 * tv + 4 * lq;
                    st_global_b64(Og + (row0 + i) * VALW + h * DV + dvs * 64 + v0, (v2u){pk2(o4[0], o4[1]), pk2(o4[2], o4[3])}); }
            }
            { const f32x4 eb = *(const LAS f32x4*)(buf + BL_EBL + (16 * w + 4 * lq) * 4);
              const bf16x8 ka0 = ldfrag(buf + BL_KH, 16 * w + l15, S64, (8 * lq) * 2), ka1 = ldfrag(buf + BL_KH, 16 * w + l15, S64, (8 * lq + 32) * 2);
#pragma unroll
              for (int tv = 0; tv < 4; ++tv) { S[tv] = S[tv] * eb;
                  S[tv] = __builtin_amdgcn_mfma_f32_16x16x32_bf16(ka0, ldfrag(vt, 16 * tv + l15, S64, (8 * lq) * 2), S[tv], 0, 0, 0);
                  S[tv] = __builtin_amdgcn_mfma_f32_16x16x32_bf16(ka1, ldfrag(vt, 16 * tv + l15, S64, (8 * lq + 32) * 2), S[tv], 0, 0, 0);
                  *(LAS v2u*)(stn + (16 * tv + l15) * S128 + (16 * w + 4 * lq) * 2) = (v2u){pk2(S[tv][0], S[tv][1]), pk2(S[tv][2], S[tv][3])}; } }
          }
        }
#undef SCAN_LD
#undef SCAN_ST
#undef SCAN_ROW0
        asm volatile("s_waitcnt vmcnt(0)" ::: "memory");
#undef SCAN_CIDX
    }
    __syncthreads();
}

__device__ __forceinline__ void wg_rows(const Frame& F, int& r0, int& rend) {
    if (F.G == 256) { r0 = 2048 * (F.bid & 7) + 64 * (F.bid >> 3); rend = r0 + 64; }
    else { const int per = (M + F.G - 1) / F.G; r0 = F.bid * per; if (r0 > M) r0 = M; rend = (r0 + per < M) ? r0 + per : M; }
}
__device__ __forceinline__ void p4_readout(LAS unsigned char* lds_, const Params& p) {
    const Frame F = mk_frame(lds_);
    const bf16* OF = (const bf16*)(p.ws + WS_OF); const bf16* OB = (const bf16*)(p.ws + WS_OB); const bf16* SR = (const bf16*)(p.ws + WS_SR); bf16* Y = (bf16*)(p.ws + WS_Y);
    int r0, rend; wg_rows(F, r0, rend);
    f32x4 g[8];
#pragma unroll
    for (int h = 0; h < 8; ++h) g[h] = *(const f32x4*)(p.in[I_GNG] + h * DV + 4 * F.lane);
    for (int r = r0 + F.wave; r < rend; r += NWAVES) {
        v2u a[8], b[8], c[8];
#pragma unroll
        for (int h = 0; h < 8; ++h) { const size_t o = (size_t)r * VALW + h * DV + 4 * F.lane; a[h] = __builtin_nontemporal_load((const v2u*)(OF + o)); b[h] = __builtin_nontemporal_load((const v2u*)(OB + o)); c[h] = __builtin_nontemporal_load((const v2u*)(SR + o)); }
#pragma unroll
        for (int h = 0; h < 8; ++h) {
            const float o0 = bf_lo(a[h].x) + bf_lo(b[h].x), o1 = bf_hi(a[h].x) + bf_hi(b[h].x), o2 = bf_lo(a[h].y) + bf_lo(b[h].y), o3 = bf_hi(a[h].y) + bf_hi(b[h].y);
            const float rstd = rsqrtf(wave_sum((o0 * o0 + o1 * o1) + (o2 * o2 + o3 * o3)) * (1.0f / DV) + EPS);
            v2u w; w.x = pk2(o0 * rstd * g[h][0] * bf_lo(c[h].x), o1 * rstd * g[h][1] * bf_hi(c[h].x)); w.y = pk2(o2 * rstd * g[h][2] * bf_lo(c[h].y), o3 * rstd * g[h][3] * bf_hi(c[h].y));
            *(v2u*)(Y + (size_t)r * D + h * DV + 4 * F.lane) = w; }
    }
}

__device__ __forceinline__ void p6_rows(LAS unsigned char* lds_, const Params& p) {
    const Frame F = mk_frame(lds_);
    LAS float* cA = (LAS float*)F.lds; LAS float* cB = cA + D; LAS float* cC = cB + D;
    const float* mod = (const float*)(p.ws + WS_MOD); bf16* A1 = (bf16*)(p.ws + WS_A1); const bf16* MIX = (const bf16*)(p.ws + WS_MIX); const float* ssq = (const float*)(p.ws + WS_SSQ);
    int r0, rend; wg_rows(F, r0, rend);
    while (r0 < rend) {
        const int bb = r0 / SEQ; const int bend = (bb + 1) * SEQ; const int r1 = rend < bend ? rend : bend; const float* mb = mod + (size_t)bb * NMOD * D;
        __syncthreads();
        { float l_[8][5];
#pragma unroll
          for (int j = 0; j < 8; ++j) { const int c = F.tid + NTHR * j; l_[j][0] = mb[2 * D + c]; l_[j][1] = p.in[I_POST1][c]; l_[j][2] = p.in[I_PRE2][c]; l_[j][3] = mb[4 * D + c]; l_[j][4] = mb[3 * D + c]; }
#pragma unroll
          for (int j = 0; j < 8; ++j) { const int c = F.tid + NTHR * j; cA[c] = l_[j][0] * l_[j][1]; cB[c] = l_[j][2] * (1.0f + l_[j][3]); cC[c] = l_[j][4]; } }
        __syncthreads();
        for (int r = r0 + F.wave; r < r1; r += NWAVES) {
            const float rstd1 = rsqrtf(wave_sum(ssq[(size_t)r * 64 + F.lane]) * (1.0f / D) + EPS);
            const float* xr = p.in[I_X] + (size_t)r * D; const bf16* mr = MIX + (size_t)r * D;
            f32x4 v[16]; float ss = 0.f;
#pragma unroll
            for (int jg = 0; jg < 16; jg += 8) {
                v2u m2[8];
#pragma unroll
                for (int j = 0; j < 8; ++j) { v[jg + j] = __builtin_nontemporal_load((const f32x4*)(xr + 256 * (jg + j) + 4 * F.lane)); m2[j] = __builtin_nontemporal_load((const v2u*)(mr + 256 * (jg + j) + 4 * F.lane)); }
#pragma unroll
                for (int j = 0; j < 8; ++j) { const f32x4 a = *(LAS f32x4*)(cA + 256 * (jg + j) + 4 * F.lane);
                    const f32x4 mx = (f32x4){bf_lo(m2[j].x), bf_hi(m2[j].x), bf_lo(m2[j].y), bf_hi(m2[j].y)};
                    const f32x4 t = v[jg + j] + a * mx * rstd1; v[jg + j] = t; ss += (t[0] * t[0] + t[1] * t[1]) + (t[2] * t[2] + t[3] * t[3]);
                    }
                asm volatile("" ::: "memory");
            }
            const float rstd2 = rsqrtf(wave_sum(ss) * (1.0f / D) + EPS);
            bf16* hrow = A1 + (size_t)r * D;
#pragma unroll
            for (int j = 0; j < 16; ++j) { const f32x4 b = *(LAS f32x4*)(cB + 256 * j + 4 * F.lane), c = *(LAS f32x4*)(cC + 256 * j + 4 * F.lane); const f32x4 o = v[j] * rstd2 * b + c;
                v2u w; w.x = pk2(o[0], o[1]); w.y = pk2(o[2], o[3]); *(v2u*)(hrow + 256 * j + 4 * F.lane) = w; if ((j & 3) == 3) asm volatile("" ::: "memory"); }
        }
        r0 = r1;
    }
    __syncthreads();
}
#define XB_DONE(j)   (4672 + 64 * (j))
#define XB_Q9(v, w)  (5184 + 32 * (8 * (v) + (w)))
__device__ __forceinline__ void p9_rows(LAS unsigned char* lds_, const Params& p) {
    const Frame F = mk_frame(lds_);
    LAS float* cA = (LAS float*)F.lds; LAS float* cB = cA + D; volatile LAS unsigned* SL = (volatile LAS unsigned*)(cB + D);
    const float* mod = (const float*)(p.ws + WS_MOD); const bf16* MIX = (const bf16*)(p.ws + WS_MIX); const bf16* MLP = (const bf16*)(p.ws + WS_MLP); const float* ssq1 = (const float*)(p.ws + WS_SSQ); const float* ssq2 = (const float*)(p.ws + WS_SSQ2);
    unsigned* bar = (unsigned*)(p.ws + WS_CTL) + CW_BAR;
    const bool loc = F.G == 256; const int NG = loc ? 8 : 4, RPG = loc ? 2048 : 4096; const unsigned target = loc ? 32u : (unsigned)F.G;
    asm volatile("s_waitcnt vmcnt(0)" ::: "memory");
    __syncthreads();
    if (F.tid == 0) { __builtin_amdgcn_s_waitcnt(0); __builtin_amdgcn_fence(__ATOMIC_RELEASE, "agent"); asm volatile("s_waitcnt vmcnt(0)" ::: "memory"); (void)xb_add(&bar[XB_DONE(loc ? (F.bid & 7) : 0)], 1u); }
    unsigned pending = (1u << NG) - 1u, idle = 0u; int v = loc ? (F.bid & 7) : (F.bid & 3);
    while (pending) {
        if ((pending >> v) & 1u) {
            __syncthreads();
            if (F.tid == 0) { unsigned rdy = xb_ld(&bar[XB_DONE(loc ? v : 0)]) >= target ? 1u : 0u;
                if (rdy) { __builtin_amdgcn_fence(__ATOMIC_ACQUIRE, "agent"); asm volatile("s_waitcnt vmcnt(0)" ::: "memory"); }
                else if (xb_ld(&bar[XB_TMO])) rdy = 2u; else if (idle > XB_SPIN_CAP) { atomicAdd(&bar[XB_TMO], 1u); rdy = 2u; }
                SL[0] = rdy; }
            __syncthreads();
            const unsigned rdy = SL[0];
            if (rdy == 2u) break;
            if (rdy == 1u) {
                pending &= ~(1u << v); idle = 0u;
                const float* mb = mod + (size_t)(loc ? (v >> 1) : v) * NMOD * D;
                { float l_[8][4];
#pragma unroll
                  for (int j = 0; j < 8; ++j) { const int c = F.tid + NTHR * j; l_[j][0] = mb[2 * D + c]; l_[j][1] = p.in[I_POST1][c]; l_[j][2] = mb[5 * D + c]; l_[j][3] = p.in[I_POST2][c]; }
#pragma unroll
                  for (int j = 0; j < 8; ++j) { const int c = F.tid + NTHR * j; cA[c] = l_[j][0] * l_[j][1]; cB[c] = l_[j][2] * l_[j][3]; } }
                __syncthreads();
                unsigned* qh = &bar[XB_Q9(v, F.wave)]; unsigned nx = 0u; if (F.lane == 0) nx = xb_add(qh, 1u);
                for (;;) {
                    const int d = __builtin_amdgcn_readfirstlane((int)nx);
                    if (d >= RPG / NWAVES) break;
                    if (F.lane == 0) nx = xb_add(qh, 1u);
                    const int r = v * RPG + d * NWAVES + F.wave;
                    const float rstd1 = rsqrtf(wave_sum(ssq1[(size_t)r * 64 + F.lane]) * (1.0f / D) + EPS), rstd2 = rsqrtf(wave_sum(ssq2[(size_t)r * 64 + F.lane]) * (1.0f / D) + EPS);
                    const float* xr = p.in[I_X] + (size_t)r * D; const bf16* mr = MIX + (size_t)r * D; const bf16* lr = MLP + (size_t)r * D; float* orow = p.out + (size_t)r * D;
#pragma unroll
                    for (int jg = 0; jg < 16; jg += 8) {
                        f32x4 xv[8]; v2u m2[8], l2[8];
#pragma unroll
                        for (int j = 0; j < 8; ++j) { const int c = 256 * (jg + j) + 4 * F.lane; xv[j] = __builtin_nontemporal_load((const f32x4*)(xr + c)); m2[j] = __builtin_nontemporal_load((const v2u*)(mr + c)); l2[j] = __builtin_nontemporal_load((const v2u*)(lr + c)); }
#pragma unroll
                        for (int j = 0; j < 8; ++j) { const int c = 256 * (jg + j) + 4 * F.lane; const f32x4 a = *(LAS f32x4*)(cA + c), b = *(LAS f32x4*)(cB + c);
                            const f32x4 mx = (f32x4){bf_lo(m2[j].x), bf_hi(m2[j].x), bf_lo(m2[j].y), bf_hi(m2[j].y)}, lx = (f32x4){bf_lo(l2[j].x), bf_hi(l2[j].x), bf_lo(l2[j].y), bf_hi(l2[j].y)};
                            const f32x4 x1 = xv[j] + a * mx * rstd1;
                            *(f32x4*)(orow + c) = x1 + b * lx * rstd2; }
                        asm volatile("" ::: "memory");
                    }
                }
            } else { ++idle; __builtin_amdgcn_s_sleep(8); }
        }
        v = (v + 1 == NG) ? 0 : v + 1;
    }
}

__global__ void __launch_bounds__(NTHR, 2) dit_fwd(Params p) {
    extern __shared__ __attribute__((aligned(16))) unsigned char lds_raw[];
    LAS unsigned char* lds = (LAS unsigned char*)lds_raw; const int G = gridDim.x, bid = blockIdx.x;
    volatile LAS unsigned* MISC = (volatile LAS unsigned*)(lds + LDS_CTL_OFF);
    if (threadIdx.x < 64) MISC[threadIdx.x] = 0u;
    __syncthreads();
    gu32* ctl = (gu32*)(p.ws + WS_CTL);
    XcdBarrier bar = xcd_barrier_post((unsigned*)(ctl + CW_BAR), MISC + 8);
    unsigned char* ws = p.ws;

    p0_adaln(lds, p);
    p0_prologue(lds, p);
    xcd_barrier(bar);
    p1_rows(lds, p);
    xcd_barrier(bar);
    {
        pg8::Gemm g{(const pg8::bf16_t*)(ws + WS_A1), (const pg8::bf16_t*)(ws + WS_WIN), MT, IN_PAD, D};
        pg8::InOrder S{G, bid};
        pg8::EpiIn E{(pg8::bf16_t*)(ws + WS_Q), (pg8::bf16_t*)(ws + WS_KB), (pg8::bf16_t*)(ws + WS_V), (pg8::bf16_t*)(ws + WS_SR), (pg8::bf16_t*)(ws + WS_U), (pg8::bf16_t*)(ws + WS_VV), (float*)(ws + WS_LR), (float*)(ws + WS_SGSTAT), 0.08838834764831845f};
        pg8::gemm_phase<pg8::EpiIn, pg8::InOrder, true, true>(lds, g, S, E);
    }
    xcd_barrier(bar);
    {
        pg8::Gemm g{(const pg8::bf16_t*)(ws + WS_A1), (const pg8::bf16_t*)(ws + WS_WIN), MT, IN_PAD, D};
        pg8::TailOrder S{G, bid};
        pg8::EpiIn E{(pg8::bf16_t*)(ws + WS_Q), (pg8::bf16_t*)(ws + WS_KB), (pg8::bf16_t*)(ws + WS_V), (pg8::bf16_t*)(ws + WS_SR), (pg8::bf16_t*)(ws + WS_U), (pg8::bf16_t*)(ws + WS_VV), (float*)(ws + WS_LR), (float*)(ws + WS_SGSTAT), 0.08838834764831845f};
        pg8::gemm_phase<pg8::EpiIn, pg8::TailOrder, true, true>(lds, g, S, E);
    }
    p3_sg(lds, p);
    p3x_deferred(lds, p);
    xcd_barrier(bar);
    p3_gla_pre(lds, p);
    xcd_barrier(bar);
    p3_gla_scan(lds, p);
    xcd_barrier(bar);
    p4_readout(lds, p);
    if (G == 256) grp_barrier<0, false, false>(bar); else xcd_barrier(bar);
    {
        pg8::Gemm g{(const pg8::bf16_t*)(ws + WS_Y), (const pg8::bf16_t*)(ws + WS_WO), M, D, D};
        pg8::StaticOrder S; S.init(M, D, G, bid);
        pg8::EpiAct<0, 1> E{(pg8::bf16_t*)(ws + WS_MIX), D, (float*)(ws + WS_SSQ)};
        pg8::gemm_phase<pg8::EpiAct<0, 1>, pg8::StaticOrder, true, true>(lds, g, S, E);
    }
    if (G == 256) grp_barrier<1, true, false>(bar); else xcd_barrier(bar);
    p6_rows(lds, p);
    if (G == 256) grp_barrier<2, false, true>(bar); else xcd_barrier(bar);
    {
        pg8::Gemm g{(const pg8::bf16_t*)(ws + WS_A1), (const pg8::bf16_t*)(ws + WS_W1), M, FF, D};
        pg8::StaticOrder S; S.init(M, FF, G, bid);
        pg8::EpiAct<3, 0> E{(pg8::bf16_t*)(ws + WS_HMID), FF, nullptr};
        pg8::gemm_phase<pg8::EpiAct<3, 0>, pg8::StaticOrder, true, true>(lds, g, S, E);
    }
    if (G == 256) grp_barrier<3, false, false>(bar); else xcd_barrier(bar);
    {
        pg8::Gemm g{(const pg8::bf16_t*)(ws + WS_HMID), (const pg8::bf16_t*)(ws + WS_W2), M, D, FF};
        pg8::StaticOrder S; S.init(M, D, G, bid);
        pg8::EpiAct<0, 1> E{(pg8::bf16_t*)(ws + WS_MLP), D, (float*)(ws + WS_SSQ2)};
        pg8::gemm_phase<pg8::EpiAct<0, 1>, pg8::StaticOrder, true, true>(lds, g, S, E);
    }
    p9_rows(lds, p);
}

extern "C" void kernel_launch(void* const* d_in, const int* in_sizes, int n_in, void* d_out, int out_size, void* d_ws, size_t ws_size, hipStream_t stream) {
    static int grid = 0;
    if (grid == 0) {
        if (n_in != 23 || in_sizes[0] != M * D || out_size != M * D || ws_size < WS_END2) { fprintf(stderr, "kernel_launch: unexpected shapes (n_in %d, in0 %d, out %d, ws %zu); nothing launched\n", n_in, n_in > 0 ? in_sizes[0] : -1, out_size, ws_size); grid = -1; return; }
        int dev = 0, cus = 0, per_cu = 0;
        if (hipGetDevice(&dev) != hipSuccess || hipDeviceGetAttribute(&cus, hipDeviceAttributeMultiprocessorCount, dev) != hipSuccess) { grid = -1; return; }
        if (hipFuncSetAttribute((const void*)dit_fwd, hipFuncAttributeMaxDynamicSharedMemorySize, LDS_BYTES) != hipSuccess) { fprintf(stderr, "kernel_launch: hipFuncSetAttribute failed\n"); grid = -1; return; }
        if (hipOccupancyMaxActiveBlocksPerMultiprocessor(&per_cu, (const void*)dit_fwd, NTHR, LDS_BYTES) != hipSuccess || per_cu < 1) { fprintf(stderr, "kernel_launch: occupancy query reports %d blocks per CU\n", per_cu); }
        (void)hipGetLastError();
        grid = cus;
    }
    if (grid < 0) return;
    if (hipMemsetAsync((char*)d_ws + WS_CTL, 0, CTL_ZERO_BYTES, stream) != hipSuccess) return;
    Params a{};
    for (int i = 0; i < 23; ++i) a.in[i] = (const float*)d_in[i];
    a.out = (float*)d_out; a.ws = (unsigned char*)d_ws;
    hipLaunchKernelGGL(dit_fwd, dim3(grid), dim3(NTHR), LDS_BYTES, stream, a);
}
```
